# Optimizing an MI355X kernel written in HIP

```python
import jax, jax.numpy as jnp
from jax import lax
import numpy as np

D_MODEL = 1024
BATCH = 8
SEQ = 2048
DEPTH = 1
DEC_BATCH = 128
DEC_SEQ = 8
PAST_LEN = 16384
PAGE_SIZE = 128

CHUNK = 128
GM_WIDTH = D_MODEL
GM_GROUPS = 8
GM_GROUP_DIM = GM_WIDTH // GM_GROUPS
RET_HEADS = 8
RET_DK = D_MODEL // RET_HEADS
RET_DV = 2 * RET_DK
RET_QK = RET_HEADS * RET_DK
RET_V = RET_HEADS * RET_DV
D_FF = 2816
N_MOD = 9
EPS = 1e-6
ROPE_BASE = 10000.0
IN_SIZES = (GM_WIDTH, GM_WIDTH, RET_QK, RET_QK, RET_V, RET_V, D_MODEL, D_MODEL)
IN_COLS = sum(IN_SIZES)
SPLIT_POINTS = tuple(int(s) for s in np.cumsum(IN_SIZES)[:-1])

kernel_name = "hybrid_gmlp_retention_macaron_adaln_step"


def rms_norm(x, gain):
    xf = x.astype(jnp.float32)
    y = xf * lax.rsqrt(jnp.mean(xf * xf, axis=-1, keepdims=True) + EPS)
    return (y * gain.astype(jnp.float32)).astype(x.dtype)


def layer_norm(x, gain, bias):
    xf = x.astype(jnp.float32)
    mu = jnp.mean(xf, axis=-1, keepdims=True)
    var = jnp.mean(jnp.square(xf - mu), axis=-1, keepdims=True)
    y = (xf - mu) * lax.rsqrt(var + EPS)
    return (y * gain.astype(jnp.float32) + bias.astype(jnp.float32)).astype(x.dtype)


def head_rms(o):
    return o * lax.rsqrt(jnp.mean(o * o, axis=-1, keepdims=True) + EPS)


def modulate(n, shift, scale):
    return n * (1 + scale) + shift


def swiglu(h, w_gate, w_up, w_down):
    return (jax.nn.silu(h @ w_gate) * (h @ w_up)) @ w_down


def rotary(x, pos):
    half = x.shape[-1] // 2
    inv = ROPE_BASE ** (-jnp.arange(half, dtype=jnp.float32) / half)
    ang = pos.astype(jnp.float32)[:, None] * inv[None, :]
    cos = jnp.cos(ang)[None, :, None, :]
    sin = jnp.sin(ang)[None, :, None, :]
    xf = x.astype(jnp.float32)
    x1, x2 = xf[..., :half], xf[..., half:]
    return jnp.concatenate([x1 * cos - x2 * sin, x1 * sin + x2 * cos], axis=-1)


def retention_log_gamma():
    return jnp.log1p(-jnp.power(2.0, -5.0 - jnp.arange(RET_HEADS, dtype=jnp.float32)))


def retention_chunk(q, k, v, S, log_gamma):
    L = q.shape[1]
    idx = jnp.arange(L, dtype=jnp.float32)
    diff = idx[:, None] - idx[None, :]
    causal = diff >= 0
    decay = jnp.where(causal[None], jnp.exp(jnp.maximum(diff, 0.0)[None] * log_gamma[:, None, None]), 0.0)
    scores = jnp.einsum('blhd,bshd->bhls', q, k) * decay[None]
    intra = jnp.einsum('bhls,bshe->blhe', scores, v)
    q_decay = jnp.exp((idx + 1.0)[:, None] * log_gamma[None, :])
    inter = jnp.einsum('blhd,bhde->blhe', q, S) * q_decay[None, :, :, None]
    k_decay = jnp.exp((L - 1.0 - idx)[:, None] * log_gamma[None, :])
    S_new = jnp.exp(L * log_gamma)[None, :, None, None] * S + jnp.einsum(
        'blhd,blhe->bhde', k * k_decay[None, :, :, None], v)
    return intra + inter, S_new


def retention(q, k, v, S0):
    B, L = q.shape[0], q.shape[1]
    lc = min(L, CHUNK)
    nc = L // lc
    log_gamma = retention_log_gamma()

    def to_blocks(a):
        return jnp.moveaxis(a.reshape(B, nc, lc, *a.shape[2:]), 1, 0)

    def step(S, qkv):
        o, S = retention_chunk(qkv[0], qkv[1], qkv[2], S, log_gamma)
        return S, o

    S_new, o = lax.scan(step, S0, (to_blocks(q), to_blocks(k), to_blocks(v)))
    o = jnp.moveaxis(o, 0, 1).reshape(B, L, RET_HEADS, RET_DV)
    return o, S_new


def chunk_spatial_mix(v, gm_ws, gm_bs):
    B, L, W = v.shape
    lc = min(L, CHUNK)
    nc = L // lc
    w = gm_ws[:, :lc, :lc] * jnp.tril(jnp.ones((lc, lc), gm_ws.dtype))
    vg = v.reshape(B, nc, lc, GM_GROUPS, GM_GROUP_DIM)
    mix = jnp.einsum('gts,bnsgd->bntgd', w, vg) + jnp.transpose(gm_bs[:, :lc])[None, None, :, :, None]
    return mix.reshape(B, L, W)


def token_mix(h, pos0, S0, w_in, gm_ln_g, gm_ln_b, gm_ws, gm_bs, w_a, w_b, w_o):
    B, L, _ = h.shape
    z = h @ w_in
    u, v, q, k, rv, rg, ga, gb = jnp.split(z, SPLIT_POINTS, axis=-1)
    u = jax.nn.gelu(u)
    v = layer_norm(jax.nn.gelu(v), gm_ln_g, gm_ln_b)
    o_a = u * chunk_spatial_mix(v, gm_ws, gm_bs)
    pos = pos0 + jnp.arange(L)
    qh = rotary(q.reshape(B, L, RET_HEADS, RET_DK), pos)
    kh = rotary(k.reshape(B, L, RET_HEADS, RET_DK), pos) * (RET_DK ** -0.5)
    vh = rv.reshape(B, L, RET_HEADS, RET_DV).astype(jnp.float32)
    o_r, S_new = retention(qh, kh, vh, S0)
    o_b = head_rms(o_r).reshape(B, L, RET_V).astype(h.dtype) * jax.nn.silu(rg)
    merged = jax.nn.sigmoid(ga) * (o_a @ w_a) + jax.nn.sigmoid(gb) * (o_b @ w_b)
    return merged @ w_o, S_new, v


def decoder_layer(x, c, pos0, S0, w_ada, b_ada, n1_g, w1_gate, w1_up, w1_down,
                  nm_g, w_in, gm_ln_g, gm_ln_b, gm_ws, gm_bs, w_a, w_b, w_o,
                  n2_g, w2_gate, w2_up, w2_down):
    m = jax.nn.silu(c) @ w_ada + b_ada
    sh1, sc1, g1, sh2, sc2, g2, sh3, sc3, g3 = jnp.split(m[:, None, :], N_MOD, axis=-1)
    h = modulate(rms_norm(x, n1_g), sh1, sc1)
    x = x + 0.5 * g1 * swiglu(h, w1_gate, w1_up, w1_down)
    h = modulate(rms_norm(x, nm_g), sh2, sc2)
    mix, S_new, v_rows = token_mix(h, pos0, S0, w_in, gm_ln_g, gm_ln_b, gm_ws, gm_bs, w_a, w_b, w_o)
    x = x + g2 * mix
    h = modulate(rms_norm(x, n2_g), sh3, sc3)
    x = x + 0.5 * g3 * swiglu(h, w2_gate, w2_up, w2_down)
    return x, S_new, v_rows


def setup_inputs(seed: int = 0) -> dict:
    key = jax.random.key(seed)
    ks = jax.random.split(key, 32)
    f32 = jnp.float32

    def nrm(k, shape, scale):
        return jax.random.normal(k, shape, f32) * scale

    def gain(k, shape):
        return 1.0 + 0.02 * jax.random.normal(k, shape, f32)

    return {
        "x_prompt": nrm(ks[0], (BATCH, SEQ, D_MODEL), 1.0),
        "x_sample": nrm(ks[1], (DEC_BATCH, DEC_SEQ, D_MODEL), 1.0),
        "state_ret": nrm(ks[2], (DEPTH, DEC_BATCH, RET_HEADS, RET_DK, RET_DV), 0.5),
        "c_prompt": nrm(ks[3], (BATCH, D_MODEL), 1.0),
        "c_sample": nrm(ks[4], (DEC_BATCH, D_MODEL), 1.0),
        "w_ada": nrm(ks[5], (DEPTH, D_MODEL, N_MOD * D_MODEL), 0.5 * D_MODEL ** -0.5),
        "b_ada": nrm(ks[6], (DEPTH, N_MOD * D_MODEL), 0.01),
        "n1_g": gain(ks[7], (DEPTH, D_MODEL)),
        "w1_gate": nrm(ks[8], (DEPTH, D_MODEL, D_FF), D_MODEL ** -0.5),
        "w1_up": nrm(ks[9], (DEPTH, D_MODEL, D_FF), D_MODEL ** -0.5),
        "w1_down": nrm(ks[10], (DEPTH, D_FF, D_MODEL), D_FF ** -0.5),
        "nm_g": gain(ks[11], (DEPTH, D_MODEL)),
        "w_in": nrm(ks[12], (DEPTH, D_MODEL, IN_COLS), D_MODEL ** -0.5),
        "gm_ln_g": gain(ks[13], (DEPTH, GM_WIDTH)),
        "gm_ln_b": nrm(ks[14], (DEPTH, GM_WIDTH), 0.01),
        "gm_ws": nrm(ks[15], (DEPTH, GM_GROUPS, CHUNK, CHUNK), CHUNK ** -0.5),
        "gm_bs": gain(ks[16], (DEPTH, GM_GROUPS, CHUNK)),
        "w_a": nrm(ks[17], (DEPTH, GM_WIDTH, D_MODEL), GM_WIDTH ** -0.5),
        "w_b": nrm(ks[18], (DEPTH, RET_V, D_MODEL), RET_V ** -0.5),
        "w_o": nrm(ks[19], (DEPTH, D_MODEL, D_MODEL), D_MODEL ** -0.5),
        "n2_g": gain(ks[20], (DEPTH, D_MODEL)),
        "w2_gate": nrm(ks[21], (DEPTH, D_MODEL, D_FF), D_MODEL ** -0.5),
        "w2_up": nrm(ks[22], (DEPTH, D_MODEL, D_FF), D_MODEL ** -0.5),
        "w2_down": nrm(ks[23], (DEPTH, D_FF, D_MODEL), D_FF ** -0.5),
        "final_g": gain(ks[24], (D_MODEL,)),
    }


def reference(x_prompt, x_sample, state_ret, c_prompt, c_sample, w_ada, b_ada, n1_g,
              w1_gate, w1_up, w1_down, nm_g, w_in, gm_ln_g, gm_ln_b, gm_ws, gm_bs,
              w_a, w_b, w_o, n2_g, w2_gate, w2_up, w2_down, final_g):
    yp, ys = x_prompt, x_sample
    sp_list, ss_list, vs_list = [], [], []
    for l in range(DEPTH):
        lw = (w_ada[l], b_ada[l], n1_g[l], w1_gate[l], w1_up[l], w1_down[l],
              nm_g[l], w_in[l], gm_ln_g[l], gm_ln_b[l], gm_ws[l], gm_bs[l],
              w_a[l], w_b[l], w_o[l], n2_g[l], w2_gate[l], w2_up[l], w2_down[l])
        S0_prompt = jnp.zeros((x_prompt.shape[0], RET_HEADS, RET_DK, RET_DV), jnp.float32)
        yp, sp, _ = decoder_layer(yp, c_prompt, 0, S0_prompt, *lw)
        ys, ss, vs = decoder_layer(ys, c_sample, PAST_LEN, state_ret[l].astype(jnp.float32), *lw)
        sp_list.append(sp)
        ss_list.append(ss)
        vs_list.append(vs)
    y_prompt = rms_norm(yp, final_g)
    y_sample = rms_norm(ys, final_g)
    ret_state_prompt = jnp.stack(sp_list, axis=0)
    ret_state_sample = jnp.stack(ss_list, axis=0)
    gmlp_v_sample = jnp.stack(vs_list, axis=0)
    return (y_prompt, y_sample, ret_state_prompt, ret_state_sample, gmlp_v_sample)
```

```cpp
#include <hip/hip_runtime.h>
#include <math.h>
#include <stdint.h>
#include <string.h>

namespace nv {
constexpr int D = 1024, DFF = 2816, NSEQ = 136, NMOD = 9216;
constexpr int MP = 16384, MS = 1024;

__device__ __forceinline__ float silu_f(float x) { return x / (1.f + expf(-x)); }
__device__ __forceinline__ float sigm_f(float x) { return 1.f / (1.f + expf(-x)); }
__device__ __forceinline__ float gelu_f(float x) { const float u = 0.7978845608028654f * (x + 0.044715f * x * x * x); return 0.5f * x * (1.f + tanhf(u)); }

struct GemmP { const float* A; const float* B; float* C; const float* aux; const float* aux2; int lda, ldb, ldc, M, N, K, rows_per_seq, seq0; float scale; int pad; };
template <int EPI>
__global__ void __launch_bounds__(256) gemm_naive(GemmP p) {
    __shared__ float As[16][65];
    __shared__ float Bs[16][64];
    const int tx = threadIdx.x & 15, ty = threadIdx.x >> 4;
    const int m0 = blockIdx.y * 64, n0 = blockIdx.x * 64;
    float acc[4][4];
#pragma unroll
    for (int i = 0; i < 4; ++i)
#pragma unroll
        for (int j = 0; j < 4; ++j) acc[i][j] = 0.f;
    for (int k0 = 0; k0 < p.K; k0 += 16) {
#pragma unroll
        for (int i = 0; i < 4; ++i) { const int e = threadIdx.x + i * 256; const int r = e >> 4, c = e & 15; int gr = m0 + r; if (gr >= p.M) gr = p.M - 1; As[c][r] = p.A[(size_t)gr * p.lda + k0 + c]; }
#pragma unroll
        for (int i = 0; i < 4; ++i) { const int e = threadIdx.x + i * 256; const int r = e >> 6, c = e & 63; Bs[r][c] = p.B[(size_t)(k0 + r) * p.ldb + n0 + c]; }
        __syncthreads();
#pragma unroll
        for (int kk = 0; kk < 16; ++kk) {
            float a[4], b[4];
#pragma unroll
            for (int i = 0; i < 4; ++i) a[i] = As[kk][ty * 4 + i];
#pragma unroll
            for (int j = 0; j < 4; ++j) b[j] = Bs[kk][tx * 4 + j];
#pragma unroll
            for (int i = 0; i < 4; ++i)
#pragma unroll
                for (int j = 0; j < 4; ++j) acc[i][j] = fmaf(a[i], b[j], acc[i][j]);
        }
        __syncthreads();
    }
#pragma unroll
    for (int i = 0; i < 4; ++i) {
        const int r = m0 + ty * 4 + i; if (r >= p.M) continue;
#pragma unroll
        for (int j = 0; j < 4; ++j) {
            const int c = n0 + tx * 4 + j; float* cp = p.C + (size_t)r * p.ldc + c; const float a = acc[i][j]; float o;
            if (EPI == 0) o = a;
            else if (EPI == 1) o = a + p.aux[c];
            else if (EPI == 2) o = gelu_f(a);
            else if (EPI == 3) o = sigm_f(a);
            else if (EPI == 4) o = silu_f(*cp) * a;
            else if (EPI == 5) o = (*cp) * silu_f(a);
            else if (EPI == 6) o = (*cp) * a;
            else if (EPI == 7) o = p.aux[(size_t)r * p.ldc + c] + (*cp) * a;
            else { const int seq = p.seq0 + r / p.rows_per_seq; o = p.aux[(size_t)r * p.ldc + c] + p.scale * p.aux2[(size_t)seq * NMOD + c] * a; }
            *cp = o;
        }
    }
}

__global__ void silu_rows(const float* cp, const float* cs, float* out) {
    const int i = blockIdx.x * 256 + threadIdx.x; if (i >= NSEQ * D) return;
    const int s = i / D, c = i % D; const float v = s < 8 ? cp[s * D + c] : cs[(s - 8) * D + c]; out[i] = silu_f(v);
}
__device__ __forceinline__ float block_sum(float v, float* red) {
#pragma unroll
    for (int o = 32; o > 0; o >>= 1) v += __shfl_xor(v, o);
    __syncthreads();
    if ((threadIdx.x & 63) == 0) red[threadIdx.x >> 6] = v;
    __syncthreads();
    return red[0] + red[1] + red[2] + red[3];
}
__global__ void __launch_bounds__(256) norm_mod(const float* x, const float* g, const float* mod, int sh_off, int sc_off, int rows_per_seq, int seq0, float* out) {
    __shared__ float red[4];
    const int r = blockIdx.x; const float4 v = ((const float4*)(x + (size_t)r * D))[threadIdx.x];
    const float ss = block_sum(v.x * v.x + v.y * v.y + v.z * v.z + v.w * v.w, red);
    const float rstd = 1.0f / sqrtf(ss * (1.f / D) + 1e-6f);
    const float4 gg = ((const float4*)g)[threadIdx.x];
    float4 o = make_float4(v.x * rstd * gg.x, v.y * rstd * gg.y, v.z * rstd * gg.z, v.w * rstd * gg.w);
    if (mod) { const int seq = seq0 + r / rows_per_seq; const float4 sh = ((const float4*)(mod + (size_t)seq * NMOD + sh_off))[threadIdx.x], sc = ((const float4*)(mod + (size_t)seq * NMOD + sc_off))[threadIdx.x];
        o.x = o.x * (1.f + sc.x) + sh.x; o.y = o.y * (1.f + sc.y) + sh.y; o.z = o.z * (1.f + sc.z) + sh.z; o.w = o.w * (1.f + sc.w) + sh.w; }
    ((float4*)(out + (size_t)r * D))[threadIdx.x] = o;
}
__global__ void __launch_bounds__(256) ln_rows(float* v, const float* g, const float* b, float* out2) {
    __shared__ float red[4];
    const int r = blockIdx.x; float4 x = ((float4*)(v + (size_t)r * D))[threadIdx.x];
    const float mu = block_sum(x.x + x.y + x.z + x.w, red) * (1.f / D);
    x.x -= mu; x.y -= mu; x.z -= mu; x.w -= mu;
    const float var = block_sum(x.x * x.x + x.y * x.y + x.z * x.z + x.w * x.w, red) * (1.f / D);
    const float rstd = 1.0f / sqrtf(var + 1e-6f);
    const float4 gg = ((const float4*)g)[threadIdx.x], bb = ((const float4*)b)[threadIdx.x];
    float4 o = make_float4(x.x * rstd * gg.x + bb.x, x.y * rstd * gg.y + bb.y, x.z * rstd * gg.z + bb.z, x.w * rstd * gg.w + bb.w);
    ((float4*)(v + (size_t)r * D))[threadIdx.x] = o;
    if (out2) ((float4*)(out2 + (size_t)r * D))[threadIdx.x] = o;
}
__global__ void rotary_qk(float* q, float* k, int R, int L, int pos0) {
    const int i = blockIdx.x * 256 + threadIdx.x; if (i >= R * 8 * 64) return;
    const int r = i / 512, h = (i / 64) & 7, j = i & 63;
    const double inv = pow(10000.0, -(double)j / 64.0); const double ang = (double)(pos0 + (r % L)) * inv;
    const float c = (float)cos(ang), s = (float)sin(ang);
    float* qp = q + (size_t)r * D + h * 128 + j; float* kp = k + (size_t)r * D + h * 128 + j;
    const float q1 = qp[0], q2 = qp[64]; qp[0] = q1 * c - q2 * s; qp[64] = q1 * s + q2 * c;
    const float k1 = kp[0], k2 = kp[64]; const float sc = 0.08838834764831845f; kp[0] = (k1 * c - k2 * s) * sc; kp[64] = (k1 * s + k2 * c) * sc;
}
__global__ void spatial_mix(float* u, const float* vn, const float* ws, const float* bs, int R, int lc) {
    const size_t i = (size_t)blockIdx.x * 256 + threadIdx.x; if (i >= (size_t)R * D) return;
    const int r = (int)(i / D), c = (int)(i % D), g = c >> 7, t = r % lc, r0 = r - t;
    float acc = bs[g * 128 + t];
    for (int s = 0; s <= t; ++s) acc = fmaf(ws[(g * 128 + t) * 128 + s], vn[(size_t)(r0 + s) * D + c], acc);
    u[i] *= acc;
}
__global__ void __launch_bounds__(256) retention_rec(const float* q, const float* k, const float* v, float* o, const float* S0, float* Sout, int L) {
    __shared__ float qs[8][128], ks[8][128];
    const int b = blockIdx.x >> 3, h = blockIdx.x & 7, e = threadIdx.x;
    const float gamma = 1.0f - exp2f(-5.0f - (float)h);
    float S[128];
#pragma unroll
    for (int d = 0; d < 128; ++d) S[d] = S0 ? S0[((size_t)(b * 8 + h) * 128 + d) * 256 + e] : 0.f;
    for (int t0 = 0; t0 < L; t0 += 8) {
        __syncthreads();
        for (int i = threadIdx.x; i < 8 * 128; i += 256) { const int tt = i >> 7, d = i & 127; const size_t off = (size_t)(b * L + t0 + tt) * D + h * 128 + d; qs[tt][d] = q[off]; ks[tt][d] = k[off]; }
        __syncthreads();
        for (int tt = 0; tt < 8; ++tt) {
            const size_t row = (size_t)(b * L + t0 + tt);
            const float vv = v[row * 2048 + h * 256 + e]; float acc = 0.f;
#pragma unroll
            for (int d = 0; d < 128; ++d) { S[d] = fmaf(ks[tt][d], vv, gamma * S[d]); acc = fmaf(qs[tt][d], S[d], acc); }
            o[row * 2048 + h * 256 + e] = acc;
        }
    }
#pragma unroll
    for (int d = 0; d < 128; ++d) Sout[((size_t)(b * 8 + h) * 128 + d) * 256 + e] = S[d];
}
__global__ void __launch_bounds__(256) head_rms(float* o, int R) {
    const int w = blockIdx.x * 4 + (threadIdx.x >> 6), lane = threadIdx.x & 63; if (w >= R * 8) return;
    float4* p = (float4*)(o + (size_t)w * 256) + lane; float4 x = *p; float s = x.x * x.x + x.y * x.y + x.z * x.z + x.w * x.w;
#pragma unroll
    for (int of = 32; of > 0; of >>= 1) s += __shfl_xor(s, of);
    const float r = 1.0f / sqrtf(s * (1.f / 256.f) + 1e-6f); x.x *= r; x.y *= r; x.z *= r; x.w *= r; *p = x;
}

template <int EPI> static void gemm(hipStream_t st, const float* A, int lda, const float* B, int ldb, float* C, int ldc, int M, int N, int K, const float* aux = nullptr, const float* aux2 = nullptr, int rps = 1, int seq0 = 0, float scale = 1.f) {
    GemmP p; memset(&p, 0, sizeof(p)); p.A = A; p.B = B; p.C = C; p.aux = aux; p.aux2 = aux2; p.lda = lda; p.ldb = ldb; p.ldc = ldc; p.M = M; p.N = N; p.K = K; p.rows_per_seq = rps; p.seq0 = seq0; p.scale = scale;
    hipLaunchKernelGGL(gemm_naive<EPI>, dim3(N / 64, (M + 63) / 64), dim3(256), 0, st, p);
}

static void forward(void* const* d_in, float* out, unsigned char* ws, hipStream_t st) {
    const float* x_prompt = (const float*)d_in[0]; const float* x_sample = (const float*)d_in[1]; const float* state_ret = (const float*)d_in[2];
    const float* c_prompt = (const float*)d_in[3]; const float* c_sample = (const float*)d_in[4]; const float* w_ada = (const float*)d_in[5]; const float* b_ada = (const float*)d_in[6];
    const float* n1_g = (const float*)d_in[7]; const float* w1_gate = (const float*)d_in[8]; const float* w1_up = (const float*)d_in[9]; const float* w1_down = (const float*)d_in[10];
    const float* nm_g = (const float*)d_in[11]; const float* w_in = (const float*)d_in[12]; const float* gm_ln_g = (const float*)d_in[13]; const float* gm_ln_b = (const float*)d_in[14];
    const float* gm_ws = (const float*)d_in[15]; const float* gm_bs = (const float*)d_in[16]; const float* w_a = (const float*)d_in[17]; const float* w_b = (const float*)d_in[18]; const float* w_o = (const float*)d_in[19];
    const float* n2_g = (const float*)d_in[20]; const float* w2_gate = (const float*)d_in[21]; const float* w2_up = (const float*)d_in[22]; const float* w2_down = (const float*)d_in[23]; const float* final_g = (const float*)d_in[24];
    float* y_prompt = out; float* y_sample = out + (size_t)MP * D; float* rs_prompt = y_sample + (size_t)MS * D; float* rs_sample = rs_prompt + (size_t)8 * 8 * 128 * 256; float* gv_sample = rs_sample + (size_t)128 * 8 * 128 * 256;
    constexpr int RG = 4096;
    size_t off = 0; auto carve = [&](size_t nfloats) { float* p = (float*)(ws + off); off += ((nfloats * 4 + 255) / 256) * 256; return p; };
    float* MOD = carve((size_t)NSEQ * NMOD); float* SC = carve((size_t)NSEQ * D);
    float* X = carve((size_t)RG * D); float* H = carve((size_t)RG * D); float* G = carve((size_t)RG * DFF);
    float* U = carve((size_t)RG * D); float* V = carve((size_t)RG * D); float* Q = carve((size_t)RG * D); float* K = carve((size_t)RG * D);
    float* RV = carve((size_t)RG * 2048); float* OR = carve((size_t)RG * 2048); float* GA = carve((size_t)RG * D); float* GB = carve((size_t)RG * D); float* MG = carve((size_t)RG * D);

    hipLaunchKernelGGL(silu_rows, dim3((NSEQ * D + 255) / 256), dim3(256), 0, st, c_prompt, c_sample, SC);
    gemm<1>(st, SC, D, w_ada, NMOD, MOD, NMOD, NSEQ, NMOD, D, b_ada);
    for (int grp = 0; grp < 5; ++grp) {
        const bool smp = grp == 4; const int R = smp ? MS : RG, L = smp ? 8 : 2048, lc = smp ? 8 : 128, seq0 = smp ? 8 : grp * 2, pos0 = smp ? 16384 : 0, nseq = R / L;
        const float* xin = smp ? x_sample : x_prompt + (size_t)grp * RG * D; float* yout = smp ? y_sample : y_prompt + (size_t)grp * RG * D;
        hipLaunchKernelGGL(norm_mod, dim3(R), dim3(256), 0, st, xin, n1_g, MOD, 0 * D, 1 * D, L, seq0, H);
        gemm<0>(st, H, D, w1_gate, DFF, G, DFF, R, DFF, D);
        gemm<4>(st, H, D, w1_up, DFF, G, DFF, R, DFF, D);
        gemm<8>(st, G, DFF, w1_down, D, X, D, R, D, DFF, xin, MOD + 2 * D, L, seq0, 0.5f);
        hipLaunchKernelGGL(norm_mod, dim3(R), dim3(256), 0, st, X, nm_g, MOD, 3 * D, 4 * D, L, seq0, H);
        gemm<2>(st, H, D, w_in + 0, 10240, U, D, R, D, D);
        gemm<2>(st, H, D, w_in + 1024, 10240, V, D, R, D, D);
        gemm<0>(st, H, D, w_in + 2048, 10240, Q, D, R, D, D);
        gemm<0>(st, H, D, w_in + 3072, 10240, K, D, R, D, D);
        gemm<0>(st, H, D, w_in + 4096, 10240, RV, 2048, R, 2048, D);
        gemm<3>(st, H, D, w_in + 8192, 10240, GA, D, R, D, D);
        gemm<3>(st, H, D, w_in + 9216, 10240, GB, D, R, D, D);
        hipLaunchKernelGGL(ln_rows, dim3(R), dim3(256), 0, st, V, gm_ln_g, gm_ln_b, smp ? gv_sample : (float*)nullptr);
        hipLaunchKernelGGL(spatial_mix, dim3((unsigned)(((size_t)R * D + 255) / 256)), dim3(256), 0, st, U, V, gm_ws, gm_bs, R, lc);
        hipLaunchKernelGGL(rotary_qk, dim3((R * 512 + 255) / 256), dim3(256), 0, st, Q, K, R, L, pos0);
        hipLaunchKernelGGL(retention_rec, dim3(nseq * 8), dim3(256), 0, st, Q, K, RV, OR, smp ? state_ret : (const float*)nullptr, smp ? rs_sample : rs_prompt + (size_t)grp * 2 * 8 * 128 * 256, L);
        hipLaunchKernelGGL(head_rms, dim3((R * 8 + 3) / 4), dim3(256), 0, st, OR, R);
        gemm<5>(st, H, D, w_in + 6144, 10240, OR, 2048, R, 2048, D);
        gemm<6>(st, U, D, w_a, D, GA, D, R, D, D);
        gemm<7>(st, OR, 2048, w_b, D, GB, D, R, D, 2048, GA);
        gemm<8>(st, GB, D, w_o, D, MG, D, R, D, D, X, MOD + 5 * D, L, seq0, 1.0f);
        hipLaunchKernelGGL(norm_mod, dim3(R), dim3(256), 0, st, MG, n2_g, MOD, 6 * D, 7 * D, L, seq0, H);
        gemm<0>(st, H, D, w2_gate, DFF, G, DFF, R, DFF, D);
        gemm<4>(st, H, D, w2_up, DFF, G, DFF, R, DFF, D);
        gemm<8>(st, G, DFF, w2_down, D, X, D, R, D, DFF, MG, MOD + 8 * D, L, seq0, 0.5f);
        hipLaunchKernelGGL(norm_mod, dim3(R), dim3(256), 0, st, X, final_g, (const float*)nullptr, 0, 0, L, seq0, yout);
    }
}
}

extern "C" void kernel_launch(void* const* d_in, const int* in_sizes, int n_in, void* d_out, int out_size, void* d_ws, size_t ws_size, hipStream_t stream) {
    nv::forward(d_in, (float*)d_out, (unsigned char*)d_ws, stream);
}
```

```cpp
#include <hip/hip_runtime.h>
#include <cstdio>
#include <cstdint>
#include <cstring>

#define LAS __attribute__((address_space(3)))
#define GAS __attribute__((address_space(1)))
typedef unsigned short bf16_t;
typedef short bf16x8 __attribute__((ext_vector_type(8)));
typedef short s16x4 __attribute__((ext_vector_type(4)));
typedef short v4i16_t __attribute__((ext_vector_type(4)));
typedef float f32x4 __attribute__((ext_vector_type(4)));
typedef float f32x2 __attribute__((ext_vector_type(2)));
typedef float f32x16 __attribute__((ext_vector_type(16)));
typedef unsigned u32x4 __attribute__((ext_vector_type(4)));
typedef unsigned u32x2 __attribute__((ext_vector_type(2)));

#ifndef MK_PER_PHASE
#define MK_PER_PHASE 0
#endif

constexpr int D = 1024, DFF = 2816, NIN = 10240, NMOD = 9216, NSEQ = 136, MP = 16384, MS = 1024, MT = 17408, NGU = 2 * DFF;
constexpr int UOLD = 3072;
constexpr float EPS = 1e-6f;
constexpr int NPHASE = 14;

constexpr size_t MiB = 1u << 20;
constexpr size_t WS_CTL = 0, CTL_ZERO_BYTES = 1 * MiB;
constexpr size_t WS_MOD = 1 * MiB, WS_ROPEC = 6 * MiB, WS_ROPES = 7 * MiB;
constexpr size_t WS_W1GU = 8 * MiB, WS_W1D = 19 * MiB, WS_W2GU = 25 * MiB, WS_W2D = 36 * MiB, WS_WIN = 42 * MiB, WS_WAB = 62 * MiB, WS_WO = 68 * MiB;
constexpr size_t WS_H = 70 * MiB;
constexpr size_t WS_UO = 104 * MiB, WS_V = 206 * MiB, WS_Q = 240 * MiB, WS_K = 274 * MiB, WS_RV = 308 * MiB, WS_SGA = 376 * MiB, WS_SGB = 410 * MiB;
constexpr size_t WS_HID = 104 * MiB;
constexpr size_t WS_ST = 444 * MiB;
constexpr size_t WS_END = 508 * MiB;
constexpr int CW_TMO = 0, CW_BAR = 4096, CW_VSTAT = 16384;

constexpr int LDS_BYTES = 147456, MISC_OFF = LDS_BYTES - 512;

#define RLX_AGENT __ATOMIC_RELAXED, __HIP_MEMORY_SCOPE_AGENT
typedef __bf16 bf16x2_t __attribute__((ext_vector_type(2)));
__device__ __forceinline__ unsigned cvt_pk_bf16(float lo, float hi) { return __builtin_bit_cast(unsigned, __builtin_convertvector((f32x2){lo, hi}, bf16x2_t)); }
__device__ __forceinline__ float bf_lo(unsigned w) { return __uint_as_float(w << 16); }
__device__ __forceinline__ float bf_hi(unsigned w) { return __uint_as_float(w & 0xffff0000u); }
__device__ __forceinline__ float fsigmoid(float x) { return __builtin_amdgcn_rcpf(1.f + __builtin_amdgcn_exp2f(-1.4426950408889634f * x)); }
__device__ __forceinline__ float fsilu(float x) { return x * fsigmoid(x); }
__device__ __forceinline__ float fgelu(float x) { return x * fsigmoid(1.5957691216057308f * (x + 0.044715f * x * x * x)); }
__device__ __forceinline__ float wave_sum(float v) {
#pragma unroll
    for (int o = 1; o < 64; o <<= 1) v += __shfl_xor(v, o);
    return v;
}
__device__ __forceinline__ int seq_of(int row) { return row < MP ? (row >> 11) : 8 + ((row - MP) >> 3); }
__device__ __forceinline__ int posidx_of(int row) { return row < MP ? (row & 2047) : 2048 + ((row - MP) & 7); }
__device__ __forceinline__ int dorig_of(int p) { return 16 * (p >> 5) + 4 * ((p >> 3) & 3) + (p & 3) + 64 * ((p >> 2) & 1); }
__device__ __forceinline__ s16x4 tr_read(const LAS unsigned char* p) { return __builtin_bit_cast(s16x4, __builtin_amdgcn_ds_read_tr16_b64_v4i16((LAS v4i16_t*)p)); }
__device__ __forceinline__ bf16x8 cat4(s16x4 a, s16x4 b) { return (bf16x8){a[0], a[1], a[2], a[3], b[0], b[1], b[2], b[3]}; }
__device__ __forceinline__ bf16x8 as_bf16x8(u32x4 v) { return __builtin_bit_cast(bf16x8, v); }

namespace pg8 {
constexpr int BM = 256, BK = 64, HALF = 128, HTB = HALF * BK * 2, STAGE_BYTES = 8 * HTB, NXCD = 8, WGM = 8;
__host__ __device__ __forceinline__ int lds_byte(int r, int c) { const int st = (r >> 4) * 2 + (c >> 5), rr = r & 15, cc = c & 31, ob = rr * 64 + cc * 2; return st * 1024 + (ob ^ (((ob >> 9) & 1) << 5)); }
__host__ __device__ __forceinline__ void stage_rc(int b, int& R, int& C) { const int st = b / 1024, sb = b % 1024, swz = sb ^ (((sb >> 9) & 1) << 5); R = (st >> 1) * 16 + swz / 64; C = (st & 1) * 32 + (swz % 64) / 2; }
__host__ __device__ __forceinline__ int perm32(int rho) { const int n = rho >> 4, i = rho & 15; return 8 * (i >> 2) + 4 * n + (i & 3); }
struct Unit { int pm, pn; };
struct Gemm { const bf16_t* A; const bf16_t* Bt; int M, N, K; };
struct StaticOrder {
    int nM, nN, nwg, G, c;
    __device__ void init(int M, int N, int G_, int c_) { nM = M / BM; nN = N / BM; nwg = nM * nN; G = G_; c = c_; }
    __device__ bool next(int i, Unit& u) const {
#ifdef DBG_REV
        long L = (long)i * G + c; if (L >= nwg) return false; { const int cnt = (nwg - c + G - 1) / G; L = (long)(cnt - 1 - i) * G + c; }
#else
        const long L = (long)i * G + c; if (L >= nwg) return false;
#endif
        int wgid = (int)L; { const int q = nwg / NXCD, r = nwg % NXCD, xcd = wgid % NXCD, off = wgid / NXCD; wgid = (xcd < r ? xcd * (q + 1) : r * (q + 1) + (xcd - r) * q) + off; }
        const int nig = WGM * nN, gid = wgid / nig, fm = gid * WGM, gsz = (nM - fm) < WGM ? (nM - fm) : WGM;
        u.pm = fm + ((wgid % nig) % gsz); u.pn = (wgid % nig) / gsz; return true;
    }
};
template <class Epi, class Sched>
__device__ __forceinline__ void gemm_phase(LAS unsigned char* lds, const Gemm g, const Sched& S, const Epi& E) {
    const int tid = threadIdx.x, wid = __builtin_amdgcn_readfirstlane(tid >> 6), lane = tid & 63, wr = wid >> 2, wc = wid & 3, fr = lane & 15, fq = lane >> 4;
    const int K = g.K, nt = K / BK;
    unsigned voffA[2], voffB[2];
#pragma unroll
    for (int i = 0; i < 2; ++i) { int R, C; stage_rc(tid * 16 + i * 8192, R, C); const int Rb = Epi::PERM ? ((R & ~31) + perm32(R & 31)) : R;
        voffA[i] = (unsigned)(R * K + C) * 2u; voffB[i] = (unsigned)(Rb * K + C) * 2u; }
    const size_t kstep = (size_t)(BK * 2);
    const size_t hstep = (size_t)HALF * K * 2;
    const size_t tstep = 2 * hstep;
    const unsigned ldsw = (unsigned)wid * 1024u;
    const int aoff = lds_byte(wr * 64 + fr, fq * 8), boff = lds_byte(wc * 32 + fr, fq * 8);
#define PG8_SA(b, h) (((b) * 2 + (h)) * HTB)
#define PG8_SB(b, h) ((4 + (b) * 2 + (h)) * HTB)
#define PG8_STAGE(bufoff, gbase, voff) do { _Pragma("unroll") for (int _i = 0; _i < 2; ++_i) \
        __builtin_amdgcn_global_load_lds((const unsigned*)((const char*)(gbase) + (voff)[_i]), (LAS unsigned*)(lds + (bufoff) + ldsw + _i * 8192), 16, 0, 0); } while (0)
#define PG8_LDA(dst, b, h) do { _Pragma("unroll") for (int m = 0; m < 4; ++m) _Pragma("unroll") for (int k = 0; k < 2; ++k) dst[m][k] = *(const LAS bf16x8*)(lds + PG8_SA(b, h) + aoff + m * 2048 + k * 1024); } while (0)
#define PG8_LDB(dst, b, h) do { _Pragma("unroll") for (int n = 0; n < 2; ++n) _Pragma("unroll") for (int k = 0; k < 2; ++k) dst[n][k] = *(const LAS bf16x8*)(lds + PG8_SB(b, h) + boff + n * 2048 + k * 1024); } while (0)
#define PG8_MMA(ai, bj, At, Bt) do { __builtin_amdgcn_s_setprio(1); _Pragma("unroll") for (int m = 0; m < 4; ++m) _Pragma("unroll") for (int n = 0; n < 2; ++n) _Pragma("unroll") for (int k = 0; k < 2; ++k) \
        acc[ai][bj][m][n] = __builtin_amdgcn_mfma_f32_16x16x32_bf16(Bt[n][k], At[m][k], acc[ai][bj][m][n], 0, 0, 0); __builtin_amdgcn_s_setprio(0); } while (0)
#define PG8_WAIT_V(n) asm volatile("s_waitcnt vmcnt(" #n ")" ::: "memory")
#define PG8_WAIT_L(n) asm volatile("s_waitcnt lgkmcnt(" #n ")" ::: "memory")
#define PG8_BAR __builtin_amdgcn_s_barrier()
#define PG8_SCHED __builtin_amdgcn_sched_barrier(0)
    Unit cur, nxt; int ui = 0;
    if (!S.next(0, cur)) return;
    f32x4 acc[2][2][4][2];
#pragma unroll
    for (int a = 0; a < 2; ++a)
#pragma unroll
        for (int b = 0; b < 2; ++b)
#pragma unroll
            for (int m = 0; m < 4; ++m)
#pragma unroll
                for (int n = 0; n < 2; ++n) acc[a][b][m][n] = (f32x4){0.f, 0.f, 0.f, 0.f};
    bf16x8 At[4][2], B0[2][2], B1[2][2];
    const char* cA = (const char*)g.A + (size_t)cur.pm * tstep; const char* cB = (const char*)g.Bt + (size_t)cur.pn * tstep;
    PG8_STAGE(PG8_SB(0, 0), cB, voffB); PG8_STAGE(PG8_SB(0, 1), cB + hstep, voffB); PG8_STAGE(PG8_SA(0, 0), cA, voffA); PG8_STAGE(PG8_SA(0, 1), cA + hstep, voffA);
    if (wr == 1) PG8_BAR;
    PG8_WAIT_V(2); PG8_BAR;
    PG8_STAGE(PG8_SB(1, 0), cB + kstep, voffB); PG8_STAGE(PG8_SA(1, 0), cA + kstep, voffA); PG8_STAGE(PG8_SB(1, 1), cB + hstep + kstep, voffB);
    PG8_WAIT_V(6); PG8_BAR;
    for (;;) {
        const bool has_next = S.next(ui + 1, nxt);
        const char* nA = has_next ? (const char*)g.A + (size_t)nxt.pm * tstep : cA; const char* nB = has_next ? (const char*)g.Bt + (size_t)nxt.pn * tstep : cB;
        for (int t = 0; t < nt; t += 2) {
            if constexpr (Epi::MID_T > 0) { if (t == Epi::MID_T) E.mid(acc, cur, wr, wc, fr, fq); }
            const bool last = (t == nt - 2);
            const char* a1 = cA + (size_t)(t + 1) * kstep;
            const char* a2 = last ? nA : cA + (size_t)(t + 2) * kstep; const char* b2 = last ? nB : cB + (size_t)(t + 2) * kstep;
            const char* a3 = a2 + kstep; const char* b3 = b2 + kstep;
            PG8_LDB(B0, 0, 0); PG8_LDB(B1, 0, 1); PG8_SCHED; PG8_LDA(At, 0, 0); PG8_STAGE(PG8_SA(1, 1), a1 + hstep, voffA);
            PG8_WAIT_V(8); PG8_WAIT_L(0); PG8_BAR; PG8_MMA(0, 0, At, B0); PG8_MMA(0, 1, At, B1); PG8_BAR; PG8_SCHED;
            PG8_LDA(At, 0, 1); PG8_STAGE(PG8_SB(0, 0), b2, voffB); PG8_STAGE(PG8_SB(0, 1), b2 + hstep, voffB); PG8_STAGE(PG8_SA(0, 0), a2, voffA);
            PG8_WAIT_V(8); PG8_WAIT_L(0); PG8_BAR; PG8_MMA(1, 0, At, B0); PG8_MMA(1, 1, At, B1); PG8_BAR; PG8_SCHED;
            PG8_LDB(B0, 1, 0); PG8_LDB(B1, 1, 1); PG8_SCHED; PG8_LDA(At, 1, 0); PG8_STAGE(PG8_SA(0, 1), a2 + hstep, voffA);
            PG8_WAIT_V(8); PG8_WAIT_L(0); PG8_BAR; PG8_MMA(0, 0, At, B0); PG8_MMA(0, 1, At, B1); PG8_BAR; PG8_SCHED;
            PG8_LDA(At, 1, 1); PG8_STAGE(PG8_SB(1, 0), b3, voffB); PG8_STAGE(PG8_SB(1, 1), b3 + hstep, voffB); PG8_STAGE(PG8_SA(1, 0), a3, voffA);
            PG8_WAIT_V(8); PG8_WAIT_L(0); PG8_BAR; PG8_MMA(1, 0, At, B0); PG8_MMA(1, 1, At, B1); PG8_BAR; PG8_SCHED;
        }
        if (wr == 0) PG8_BAR;
        E(acc, cur, wr, wc, fr, fq);
        if (!has_next) break;
#pragma unroll
        for (int a = 0; a < 2; ++a)
#pragma unroll
            for (int b = 0; b < 2; ++b)
#pragma unroll
                for (int m = 0; m < 4; ++m)
#pragma unroll
                    for (int n = 0; n < 2; ++n) acc[a][b][m][n] = (f32x4){0.f, 0.f, 0.f, 0.f};
        cur = nxt; cA = nA; cB = nB; ++ui;
        if (wr == 1) PG8_BAR;
    }
    PG8_WAIT_V(0);
    PG8_BAR;
#ifdef DBG_REDO
    E(acc, cur, wr, wc, fr, fq);
#endif
#undef PG8_SA
#undef PG8_SB
#undef PG8_STAGE
#undef PG8_LDA
#undef PG8_LDB
#undef PG8_MMA
#undef PG8_WAIT_V
#undef PG8_WAIT_L
#undef PG8_BAR
#undef PG8_SCHED
}
}
using pg8::Unit;
typedef const f32x4 (&AccC)[2][2][4][2];
typedef f32x4 (&AccM)[2][2][4][2];

struct EpiGateUp {
    static constexpr bool PERM = true; static constexpr int MID_T = 0;
    bf16_t* HID;
    __device__ __forceinline__ void operator()(AccC acc, const Unit& u, int wr, int wc, int fr, int fq) const {
        const int row0 = u.pm * 256 + wr * 64 + fr, col0 = u.pn * 128 + wc * 32 + 8 * fq;
#pragma unroll
        for (int ai = 0; ai < 2; ++ai)
#pragma unroll
            for (int m = 0; m < 4; ++m) {
                const f32x4 g0 = acc[ai][0][m][0], g1 = acc[ai][0][m][1], u0 = acc[ai][1][m][0], u1 = acc[ai][1][m][1];
                u32x4 w;
                w.x = cvt_pk_bf16(fsilu(g0[0]) * u0[0], fsilu(g0[1]) * u0[1]); w.y = cvt_pk_bf16(fsilu(g0[2]) * u0[2], fsilu(g0[3]) * u0[3]);
                w.z = cvt_pk_bf16(fsilu(g1[0]) * u1[0], fsilu(g1[1]) * u1[1]); w.w = cvt_pk_bf16(fsilu(g1[2]) * u1[2], fsilu(g1[3]) * u1[3]);
                *(u32x4*)(HID + (size_t)(row0 + ai * 128 + m * 16) * DFF + col0) = w;
            }
    }
};
struct EpiResid {
    static constexpr bool PERM = false; static constexpr int MID_T = 0;
    const float* xin_p; const float* xin_s; float* X; const float* mod; int goff; float scale;
    __device__ __forceinline__ void operator()(AccC acc, const Unit& u, int wr, int wc, int fr, int fq) const {
        const int row0 = u.pm * 256 + wr * 64 + fr, col0 = u.pn * 256 + wc * 32 + 4 * fq;
        const float* xin = (u.pm < MP / 256) ? xin_p : xin_s - (size_t)MP * D;
#pragma unroll
        for (int ai = 0; ai < 2; ++ai)
#pragma unroll
            for (int m = 0; m < 4; ++m) {
                const int row = row0 + ai * 128 + m * 16; const float* gp = mod + (size_t)seq_of(row) * NMOD + goff + col0; const size_t off = (size_t)row * D + col0;
#pragma unroll
                for (int bj = 0; bj < 2; ++bj)
#pragma unroll
                    for (int n = 0; n < 2; ++n) { const f32x4 xv = *(const f32x4*)(xin + off + bj * 128 + n * 16), gv = *(const f32x4*)(gp + bj * 128 + n * 16);
                        *(f32x4*)(X + off + bj * 128 + n * 16) = xv + scale * gv * acc[ai][bj][m][n]; }
                if (m & 1) asm volatile("" ::: "memory");
            }
    }
};
struct EpiWin {
    static constexpr bool PERM = true; static constexpr int MID_T = 0;
    bf16_t *UO, *V, *Q, *K, *RV, *SGA, *SGB; unsigned long long* vstat; const float* ropec; const float* ropes;
    template <int ACT> __device__ __forceinline__ void plain(AccC acc, bf16_t* dst, int ld, int cbase, int row0, int cw) const {
#pragma unroll
        for (int ai = 0; ai < 2; ++ai)
#pragma unroll
            for (int m = 0; m < 4; ++m) { bf16_t* rowp = dst + (size_t)(row0 + ai * 128 + m * 16) * ld + cbase + cw;
#pragma unroll
                for (int bj = 0; bj < 2; ++bj) { f32x4 v0 = acc[ai][bj][m][0], v1 = acc[ai][bj][m][1];
#pragma unroll
                    for (int i = 0; i < 4; ++i) { if (ACT == 1) { v0[i] = fgelu(v0[i]); v1[i] = fgelu(v1[i]); } else if (ACT == 2) { v0[i] = fsilu(v0[i]); v1[i] = fsilu(v1[i]); } else if (ACT == 3) { v0[i] = fsigmoid(v0[i]); v1[i] = fsigmoid(v1[i]); } }
                    u32x4 w; w.x = cvt_pk_bf16(v0[0], v0[1]); w.y = cvt_pk_bf16(v0[2], v0[3]); w.z = cvt_pk_bf16(v1[0], v1[1]); w.w = cvt_pk_bf16(v1[2], v1[3]);
                    *(u32x4*)(rowp + bj * 128) = w; }
                __builtin_amdgcn_sched_barrier(0); }
    }
    __device__ __forceinline__ void operator()(AccC acc, const Unit& u, int wr, int wc, int fr, int fq) const {
        const int pn = u.pn, row0 = u.pm * 256 + wr * 64 + fr, cw = wc * 32 + 8 * fq;
        if (pn < 4) plain<1>(acc, UO, UOLD, 256 * pn, row0, cw);
        else if (pn < 8) {
            const int cbase = 256 * (pn - 4);
#pragma unroll
            for (int ai = 0; ai < 2; ++ai)
#pragma unroll
                for (int m = 0; m < 4; ++m) { const int row = row0 + ai * 128 + m * 16; bf16_t* rowp = V + (size_t)row * D + cbase + cw; float s1 = 0.f, s2 = 0.f;
#pragma unroll
                    for (int bj = 0; bj < 2; ++bj) { f32x4 v0 = acc[ai][bj][m][0], v1 = acc[ai][bj][m][1];
#pragma unroll
                        for (int i = 0; i < 4; ++i) { v0[i] = fgelu(v0[i]); v1[i] = fgelu(v1[i]); }
                        u32x4 w; w.x = cvt_pk_bf16(v0[0], v0[1]); w.y = cvt_pk_bf16(v0[2], v0[3]); w.z = cvt_pk_bf16(v1[0], v1[1]); w.w = cvt_pk_bf16(v1[2], v1[3]);
                        *(u32x4*)(rowp + bj * 128) = w;
#pragma unroll
                        for (int i = 0; i < 4; ++i) { const float a = bf_lo(w[i]), b = bf_hi(w[i]); s1 += a + b; s2 += a * a + b * b; } }
                    s1 += __shfl_xor(s1, 16); s1 += __shfl_xor(s1, 32); s2 += __shfl_xor(s2, 16); s2 += __shfl_xor(s2, 32);
                    if (fq == 0) { atomicAdd(vstat + 2 * row, (unsigned long long)(long long)__builtin_rintf(s1 * 16777216.f)); atomicAdd(vstat + 2 * row + 1, (unsigned long long)(long long)__builtin_rintf(s2 * 16777216.f)); }
                    __builtin_amdgcn_sched_barrier(0); }
        }
        else if (pn < 16) {
            const bool isk = pn >= 12; bf16_t* dst = isk ? K : Q; const int cbase = 256 * (pn - (isk ? 12 : 8)); const float ks = isk ? 0.08838834764831845f : 1.0f; const int j0 = 16 * wc + 4 * fq;
#pragma unroll
            for (int ai = 0; ai < 2; ++ai)
#pragma unroll
                for (int m = 0; m < 4; ++m) { const int row = row0 + ai * 128 + m * 16; const int pi = posidx_of(row);
                    const f32x4 c4 = *(const f32x4*)(ropec + pi * 64 + j0) * ks, s4 = *(const f32x4*)(ropes + pi * 64 + j0) * ks; bf16_t* rowp = dst + (size_t)row * D + cbase + cw;
#pragma unroll
                    for (int bj = 0; bj < 2; ++bj) { const f32x4 x1 = acc[ai][bj][m][0], x2 = acc[ai][bj][m][1]; const f32x4 o1 = x1 * c4 - x2 * s4, o2 = x1 * s4 + x2 * c4;
                        u32x4 w; w.x = cvt_pk_bf16(o1[0], o1[1]); w.y = cvt_pk_bf16(o1[2], o1[3]); w.z = cvt_pk_bf16(o2[0], o2[1]); w.w = cvt_pk_bf16(o2[2], o2[3]);
                        *(u32x4*)(rowp + bj * 128) = w; }
                    __builtin_amdgcn_sched_barrier(0); }
        }
        else if (pn < 24) plain<0>(acc, RV, 2048, 256 * (pn - 16), row0, cw);
        else if (pn < 32) plain<2>(acc, UO, UOLD, 1024 + 256 * (pn - 24), row0, cw);
        else if (pn < 36) plain<3>(acc, SGA, D, 256 * (pn - 32), row0, cw);
        else plain<3>(acc, SGB, D, 256 * (pn - 36), row0, cw);
    }
};
struct EpiMerged {
    static constexpr bool PERM = true; static constexpr int MID_T = 16;
    const bf16_t *SGA, *SGB; bf16_t* OUT;
    __device__ __forceinline__ void mid(AccM acc, const Unit& u, int wr, int wc, int fr_, int fq_) const {
        int fr = fr_, fq = fq_; asm volatile("" : "+v"(fr), "+v"(fq));
        const int row0 = u.pm * 256 + wr * 64 + fr, col0 = u.pn * 256 + wc * 32 + 8 * fq;
#pragma unroll
        for (int ai = 0; ai < 2; ++ai)
#pragma unroll
            for (int m = 0; m < 4; ++m) { const size_t off = (size_t)(row0 + ai * 128 + m * 16) * D + col0;
#pragma unroll
                for (int bj = 0; bj < 2; ++bj) { const u32x4 a = *(const u32x4*)(SGA + off + bj * 128), b = *(const u32x4*)(SGB + off + bj * 128);
#pragma unroll
                    for (int i = 0; i < 2; ++i) { acc[ai][bj][m][0][2 * i] *= bf_lo(a[i]) * __builtin_amdgcn_rcpf(fmaxf(bf_lo(b[i]), 1e-30f)); acc[ai][bj][m][0][2 * i + 1] *= bf_hi(a[i]) * __builtin_amdgcn_rcpf(fmaxf(bf_hi(b[i]), 1e-30f));
                        acc[ai][bj][m][1][2 * i] *= bf_lo(a[2 + i]) * __builtin_amdgcn_rcpf(fmaxf(bf_lo(b[2 + i]), 1e-30f)); acc[ai][bj][m][1][2 * i + 1] *= bf_hi(a[2 + i]) * __builtin_amdgcn_rcpf(fmaxf(bf_hi(b[2 + i]), 1e-30f)); } }
                asm volatile("" ::: "memory"); }
    }
    __device__ __forceinline__ void operator()(AccC acc, const Unit& u, int wr, int wc, int fr, int fq) const {
        const int row0 = u.pm * 256 + wr * 64 + fr, col0 = u.pn * 256 + wc * 32 + 8 * fq;
#pragma unroll
        for (int ai = 0; ai < 2; ++ai)
#pragma unroll
            for (int m = 0; m < 4; ++m) { const size_t off = (size_t)(row0 + ai * 128 + m * 16) * D + col0;
#pragma unroll
                for (int bj = 0; bj < 2; ++bj) { const u32x4 b = *(const u32x4*)(SGB + off + bj * 128); const f32x4 v0 = acc[ai][bj][m][0], v1 = acc[ai][bj][m][1];
                    u32x4 w; w.x = cvt_pk_bf16(v0[0] * bf_lo(b[0]), v0[1] * bf_hi(b[0])); w.y = cvt_pk_bf16(v0[2] * bf_lo(b[1]), v0[3] * bf_hi(b[1]));
                    w.z = cvt_pk_bf16(v1[0] * bf_lo(b[2]), v1[1] * bf_hi(b[2])); w.w = cvt_pk_bf16(v1[2] * bf_lo(b[3]), v1[3] * bf_hi(b[3]));
                    *(u32x4*)(OUT + off + bj * 128) = w; }
                if (m & 1) asm volatile("" ::: "memory"); }
    }
};

#define XB_TMO      128
#define XB_XCNT(j)  (256  + 64 * (j))
#define XB_XSUB(j)  (1280 + 64 * (j))
#define XB_XGEN(j)  (2304 + 64 * (j))
#define XB_TOP      3328
#define XB_TOPGEN   3392
#define XCD_BAR_WORDS 3456
#define XB_SPIN_CAP (1u << 20)
__device__ __forceinline__ unsigned xb_ld(unsigned* p)              { return __hip_atomic_load(p, __ATOMIC_RELAXED, __HIP_MEMORY_SCOPE_AGENT); }
__device__ __forceinline__ unsigned xb_add(unsigned* p, unsigned v) { return __hip_atomic_fetch_add(p, v, __ATOMIC_RELAXED, __HIP_MEMORY_SCOPE_AGENT); }
__device__ __forceinline__ unsigned xb_xcc_id() { return (unsigned)__builtin_amdgcn_s_getreg((3 << 11) | 20) & 0xFu; }
#define XB_SPIN(cond, bar) do { unsigned _sp = 0; while (cond) { __builtin_amdgcn_s_sleep(1); \
    if ((++_sp & 255u) == 0u) { if (xb_ld(&(bar)[XB_TMO])) break; if (_sp > XB_SPIN_CAP) { atomicAdd(&(bar)[XB_TMO], 1u); break; } } } } while (0)
struct XcdBarrier { unsigned* bar; unsigned x; volatile LAS unsigned* st; };
__device__ __forceinline__ XcdBarrier xcd_barrier_post(unsigned* bar, volatile LAS unsigned* st) {
    XcdBarrier b; b.bar = bar; b.x = xb_xcc_id(); b.st = st;
    if (threadIdx.x == 0) (void)xb_add(&bar[XB_XCNT(b.x)], 1u);
    return b;
}
__device__ __forceinline__ void xcd_barrier_complete(unsigned* bar, unsigned x, unsigned& nloc, unsigned& nx) {
    const unsigned G = gridDim.x * gridDim.y * gridDim.z;
    unsigned sum, cnt, mine, sp = 0u;
    for (;;) {
        sum = 0u; cnt = 0u; mine = 0u;
#pragma unroll
        for (unsigned j = 0; j < 16; ++j) { const unsigned c = xb_ld(&bar[XB_XCNT(j)]); sum += c; cnt += (c > 0u) ? 1u : 0u; mine = (j == x) ? c : mine; }
        if (sum == G) break;
        __builtin_amdgcn_s_sleep(1);
        if ((++sp & 255u) == 0u) { if (xb_ld(&bar[XB_TMO])) break; if (sp > XB_SPIN_CAP) { atomicAdd(&bar[XB_TMO], 1u); break; } }
    }
    nloc = mine > 0u ? mine : 1u; nx = cnt > 0u ? cnt : 1u;
}
__device__ __forceinline__ void xcd_barrier(const XcdBarrier& b) {
    asm volatile("s_waitcnt vmcnt(0)" ::: "memory");
    __syncthreads();
    if (threadIdx.x == 0) {
        unsigned* bar = b.bar;
        __builtin_amdgcn_s_waitcnt(0);
        unsigned nloc = b.st[0], nx = b.st[1];
        if (nloc == 0u) { xcd_barrier_complete(bar, b.x, nloc, nx); b.st[0] = nloc; b.st[1] = nx; }
        const unsigned old = xb_add(&bar[XB_XSUB(b.x)], 1u);
        const unsigned gen = old / nloc;
        if (old + 1u == (gen + 1u) * nloc) {
            __builtin_amdgcn_fence(__ATOMIC_RELEASE, "agent");
            asm volatile("s_waitcnt vmcnt(0)" ::: "memory");
            const unsigned og = xb_add(&bar[XB_TOP], 1u);
            const unsigned tg = og / nx;
            if (og + 1u == (tg + 1u) * nx) xb_add(&bar[XB_TOPGEN], 1u);
            else XB_SPIN(xb_ld(&bar[XB_TOPGEN]) == tg, bar);
            __builtin_amdgcn_fence(__ATOMIC_ACQUIRE, "agent");
            xb_add(&bar[XB_XGEN(b.x)], 1u);
            asm volatile("s_waitcnt vmcnt(0)" ::: "memory");
        } else {
            XB_SPIN(xb_ld(&bar[XB_XGEN(b.x)]) == gen, bar);
            __builtin_amdgcn_fence(__ATOMIC_ACQUIRE, "agent");
            asm volatile("s_waitcnt vmcnt(0)" ::: "memory");
        }
    }
    __syncthreads();
}

struct Args { const float* in[25]; float* out; unsigned char* ws; int ph_lo, ph_hi; };
struct Frame {
    LAS unsigned char* lds; int tid, lane, wave, vcu, G;
    const float *x_prompt, *x_sample, *state_ret, *c_prompt, *c_sample, *w_ada, *b_ada, *n1_g, *w1_gate, *w1_up, *w1_down, *nm_g, *w_in, *gm_ln_g, *gm_ln_b, *gm_ws, *gm_bs, *w_a, *w_b, *w_o, *n2_g, *w2_gate, *w2_up, *w2_down, *final_g;
    float *X, *rs_prompt, *rs_sample, *gv_sample;
    float *MOD, *ROPEC, *ROPES; unsigned long long* VSTAT;
    bf16_t *W1GU, *W1D, *W2GU, *W2D, *WIN, *WAB, *WO, *H, *UO, *V, *Q, *K, *RV, *SGA, *SGB, *HID, *ST;
};

__device__ __forceinline__ int dest_row(int map, int n) {
    if (map == 0) return n;
    if (map == 1) return ((n >> 7) << 8) + (n & 127);
    if (map == 2) return ((n >> 7) << 8) + 128 + (n & 127);
    if (n < 2048 || n >= 4096) return n;
    const int d = n & 127, j = d & 63, half = d >> 6;
    return (n & ~127) + 32 * (j >> 4) + 8 * ((j >> 2) & 3) + 4 * half + (j & 3);
}
__device__ __forceinline__ void p0_transpose_item(const float* W, int N, bf16_t* WT, int Kdst, int koff, int map, LAS float* scr, int item, int lane) {
    const int nblk = N / 32, kb = item / nblk, nb = item % nblk, k0 = 64 * kb, n0 = 32 * nb;
#pragma unroll 8
    for (int i = 0; i < 32; ++i) { const int kk = 2 * i + (lane >> 5); scr[kk * 33 + (lane & 31)] = W[(size_t)(k0 + kk) * N + n0 + (lane & 31)]; }
    asm volatile("s_waitcnt lgkmcnt(0)" ::: "memory");
    const int c = lane & 7;
#pragma unroll
    for (int j = 0; j < 4; ++j) { const int n = (lane >> 3) + 8 * j; const LAS float* s = scr + (8 * c) * 33 + n;
        u32x4 o; o.x = cvt_pk_bf16(s[0 * 33], s[1 * 33]); o.y = cvt_pk_bf16(s[2 * 33], s[3 * 33]); o.z = cvt_pk_bf16(s[4 * 33], s[5 * 33]); o.w = cvt_pk_bf16(s[6 * 33], s[7 * 33]);
        *(u32x4*)(WT + (size_t)dest_row(map, n0 + n) * Kdst + koff + k0 + 8 * c) = o; }
    asm volatile("s_waitcnt lgkmcnt(0)" ::: "memory");
}
__device__ __forceinline__ void p0_prologue(Frame& F) {
    {
        LAS float* part = (LAS float*)F.lds;
        const int c = F.lane & 31, h = F.lane >> 5;
        for (int it = F.vcu; it < NMOD / 32; it += F.G) {
            const int n0 = 32 * it;
            f32x16 acc[5];
#pragma unroll
            for (int r = 0; r < 5; ++r)
#pragma unroll
                for (int i = 0; i < 16; ++i) acc[r][i] = 0.f;
            for (int ks = 0; ks < 8; ++ks) {
                const int k0 = 128 * F.wave + 16 * ks + 8 * h;
                float bv[8];
#pragma unroll
                for (int j = 0; j < 8; ++j) bv[j] = F.w_ada[(size_t)(k0 + j) * NMOD + n0 + c];
                u32x4 bw; bw.x = cvt_pk_bf16(bv[0], bv[1]); bw.y = cvt_pk_bf16(bv[2], bv[3]); bw.z = cvt_pk_bf16(bv[4], bv[5]); bw.w = cvt_pk_bf16(bv[6], bv[7]);
#pragma unroll
                for (int rt = 0; rt < 5; ++rt) {
                    const int row = 32 * rt + c; u32x4 aw = (u32x4){0u, 0u, 0u, 0u};
                    if (row < NSEQ) { const float* cp = (row < 8 ? F.c_prompt + (size_t)row * D : F.c_sample + (size_t)(row - 8) * D) + k0; const f32x4 a0 = *(const f32x4*)cp, a1 = *(const f32x4*)(cp + 4);
                        aw.x = cvt_pk_bf16(fsilu(a0[0]), fsilu(a0[1])); aw.y = cvt_pk_bf16(fsilu(a0[2]), fsilu(a0[3])); aw.z = cvt_pk_bf16(fsilu(a1[0]), fsilu(a1[1])); aw.w = cvt_pk_bf16(fsilu(a1[2]), fsilu(a1[3])); }
                    acc[rt] = __builtin_amdgcn_mfma_f32_32x32x16_bf16(as_bf16x8(aw), as_bf16x8(bw), acc[rt], 0, 0, 0);
                }
            }
#pragma unroll
            for (int rt = 0; rt < 5; ++rt)
#pragma unroll
                for (int r = 0; r < 16; ++r) { const int row = 32 * rt + (r & 3) + 8 * (r >> 2) + 4 * h; if (row < NSEQ) part[(F.wave * NSEQ + row) * 32 + c] = acc[rt][r]; }
            __syncthreads();
            for (int i = F.tid; i < NSEQ * 32; i += 512) { const int row = i >> 5, col = i & 31; float sum = F.b_ada[n0 + col];
#pragma unroll
                for (int w = 0; w < 8; ++w) sum += part[w * NSEQ * 32 + i];
                F.MOD[(size_t)row * NMOD + n0 + col] = sum; }
            __syncthreads();
        }
    }
    for (int i = F.vcu * 512 + F.tid; i < 2 * MT; i += F.G * 512) F.VSTAT[i] = 0ull;
    for (int i = F.vcu * 512 + F.tid; i < 2056 * 64; i += F.G * 512) {
        const int pi = i >> 6, j = i & 63; const int pos = pi < 2048 ? pi : 16384 + (pi - 2048);
        double inv = 1.0; for (int q = 0; q < j; ++q) inv *= 0.8659643233600653;
        const double ang = (double)pos * inv; const double kq = __builtin_rint(ang * 0.6366197723675814); const double r = ang - kq * 1.5707963267948966, r2 = r * r;
        const double sr = r * (1.0 + r2 * (-1.0 / 6 + r2 * (1.0 / 120 + r2 * (-1.0 / 5040 + r2 * (1.0 / 362880 + r2 * (-1.0 / 39916800 + r2 * (1.0 / 6227020800.0)))))));
        const double cr = 1.0 + r2 * (-0.5 + r2 * (1.0 / 24 + r2 * (-1.0 / 720 + r2 * (1.0 / 40320 + r2 * (-1.0 / 3628800 + r2 * (1.0 / 479001600.0))))));
        const int qd = ((int)kq) & 3; const double s = (qd == 0) ? sr : (qd == 1) ? cr : (qd == 2) ? -sr : -cr, c = (qd == 0) ? cr : (qd == 1) ? -sr : (qd == 2) ? -cr : sr;
        F.ROPEC[i] = (float)c; F.ROPES[i] = (float)s;
    }
    LAS float* scr = (LAS float*)(F.lds + F.wave * 16384);
    const int gw = F.vcu * 8 + F.wave, NGW = F.G * 8;
    constexpr int I_G = (D / 64) * (DFF / 32), I_D = (DFF / 64) * (D / 32), I_IN = (D / 64) * (NIN / 32), I_A = (D / 64) * (D / 32), I_B = (2048 / 64) * (D / 32);
    constexpr int NITEMS = 4 * I_G + 2 * I_D + I_IN + 2 * I_A + I_B;
    for (int it = gw; it < NITEMS; it += NGW) {
        int r = it;
        if (r < I_IN) { p0_transpose_item(F.w_in, NIN, F.WIN, D, 0, 3, scr, r, F.lane); continue; } r -= I_IN;
        if (r < I_G) { p0_transpose_item(F.w1_gate, DFF, F.W1GU, D, 0, 1, scr, r, F.lane); continue; } r -= I_G;
        if (r < I_G) { p0_transpose_item(F.w1_up, DFF, F.W1GU, D, 0, 2, scr, r, F.lane); continue; } r -= I_G;
        if (r < I_D) { p0_transpose_item(F.w1_down, D, F.W1D, DFF, 0, 0, scr, r, F.lane); continue; } r -= I_D;
        if (r < I_G) { p0_transpose_item(F.w2_gate, DFF, F.W2GU, D, 0, 1, scr, r, F.lane); continue; } r -= I_G;
        if (r < I_G) { p0_transpose_item(F.w2_up, DFF, F.W2GU, D, 0, 2, scr, r, F.lane); continue; } r -= I_G;
        if (r < I_D) { p0_transpose_item(F.w2_down, D, F.W2D, DFF, 0, 0, scr, r, F.lane); continue; } r -= I_D;
        if (r < I_A) { p0_transpose_item(F.w_a, D, F.WAB, 3072, 0, 0, scr, r, F.lane); continue; } r -= I_A;
        if (r < I_B) { p0_transpose_item(F.w_b, D, F.WAB, 3072, 1024, 0, scr, r, F.lane); continue; } r -= I_B;
        p0_transpose_item(F.w_o, D, F.WO, D, 0, 0, scr, r, F.lane);
    }
}

__device__ __forceinline__ void norm_mod_phase(Frame& F, const float* xp, const float* xs, const float* gain, int shoff, int scoff) {
    const int gw = F.vcu * 8 + F.wave, NGW = F.G * 8;
    f32x4 g4[4];
#pragma unroll
    for (int j = 0; j < 4; ++j) g4[j] = *(const f32x4*)(gain + 4 * F.lane + 256 * j);
    for (int row = gw; row < MT; row += NGW) {
        const float* xr = (row < MP ? xp + (size_t)row * D : xs + (size_t)(row - MP) * D) + 4 * F.lane;
        f32x4 v[4]; float ss = 0.f;
#pragma unroll
        for (int j = 0; j < 4; ++j) { v[j] = *(const f32x4*)(xr + 256 * j); ss += (v[j][0] * v[j][0] + v[j][1] * v[j][1]) + (v[j][2] * v[j][2] + v[j][3] * v[j][3]); }
        const float rstd = 1.0f / sqrtf(wave_sum(ss) * (1.f / D) + EPS);
        const float* mp = F.MOD + (size_t)seq_of(row) * NMOD + 4 * F.lane; bf16_t* hp = F.H + (size_t)row * D + 4 * F.lane;
#pragma unroll
        for (int j = 0; j < 4; ++j) { const f32x4 sh = *(const f32x4*)(mp + shoff + 256 * j), sc = *(const f32x4*)(mp + scoff + 256 * j); const f32x4 o = v[j] * rstd * g4[j] * (1.f + sc) + sh;
            u32x2 w; w.x = cvt_pk_bf16(o[0], o[1]); w.y = cvt_pk_bf16(o[2], o[3]); *(u32x2*)(hp + 256 * j) = w; }
    }
}
__device__ __forceinline__ void final_norm_phase(Frame& F) {
    const int gw = F.vcu * 8 + F.wave, NGW = F.G * 8;
    f32x4 g4[4];
#pragma unroll
    for (int j = 0; j < 4; ++j) g4[j] = *(const f32x4*)(F.final_g + 4 * F.lane + 256 * j);
    for (int row = gw; row < MT; row += NGW) {
        float* xr = F.X + (size_t)row * D + 4 * F.lane; f32x4 v[4]; float ss = 0.f;
#pragma unroll
        for (int j = 0; j < 4; ++j) { v[j] = *(const f32x4*)(xr + 256 * j); ss += (v[j][0] * v[j][0] + v[j][1] * v[j][1]) + (v[j][2] * v[j][2] + v[j][3] * v[j][3]); }
        const float rstd = 1.0f / sqrtf(wave_sum(ss) * (1.f / D) + EPS);
#pragma unroll
        for (int j = 0; j < 4; ++j) *(f32x4*)(xr + 256 * j) = v[j] * rstd * g4[j];
    }
}

__device__ __forceinline__ void ln_stats(const unsigned long long* vstat, int row, float& mu, float& rstd) { const long long a = (long long)vstat[2 * row], b = (long long)vstat[2 * row + 1];
    mu = (float)a * (1.f / (16777216.f * D)); const float var = (float)b * (1.f / (16777216.f * D)) - mu * mu; rstd = 1.0f / sqrtf(fmaxf(var, 0.f) + EPS); }
__device__ __forceinline__ void ln8(const u32x4 raw, float mu, float rstd, const float* lng, const float* lnb, float (&o)[8]) {
    const f32x4 g0 = *(const f32x4*)lng, g1 = *(const f32x4*)(lng + 4), b0 = *(const f32x4*)lnb, b1 = *(const f32x4*)(lnb + 4);
    o[0] = (bf_lo(raw.x) - mu) * rstd * g0[0] + b0[0]; o[1] = (bf_hi(raw.x) - mu) * rstd * g0[1] + b0[1]; o[2] = (bf_lo(raw.y) - mu) * rstd * g0[2] + b0[2]; o[3] = (bf_hi(raw.y) - mu) * rstd * g0[3] + b0[3];
    o[4] = (bf_lo(raw.z) - mu) * rstd * g1[0] + b1[0]; o[5] = (bf_hi(raw.z) - mu) * rstd * g1[1] + b1[1]; o[6] = (bf_lo(raw.w) - mu) * rstd * g1[2] + b1[2]; o[7] = (bf_hi(raw.w) - mu) * rstd * g1[3] + b1[3];
}
__device__ __forceinline__ void gmlp_tile(Frame& F, int tile) {
    const int grp = tile & 7, n = (tile >> 3) & 15, b = tile >> 7; const int rowbase = b * 2048 + 128 * n, colbase = 128 * grp;
    LAS unsigned char* Vs = F.lds;
    const int fr = F.lane & 15, fq = F.lane >> 4;
#pragma unroll
    for (int i = 0; i < 4; ++i) { const int piece = F.tid + 512 * i, row = piece >> 4, ch = piece & 15;
        const u32x4 raw = *(const u32x4*)(F.V + (size_t)(rowbase + row) * D + colbase + 8 * ch); float mu, rstd; ln_stats(F.VSTAT, rowbase + row, mu, rstd);
        float o[8]; ln8(raw, mu, rstd, F.gm_ln_g + colbase + 8 * ch, F.gm_ln_b + colbase + 8 * ch, o);
        u32x4 w; w.x = cvt_pk_bf16(o[0], o[1]); w.y = cvt_pk_bf16(o[2], o[3]); w.z = cvt_pk_bf16(o[4], o[5]); w.w = cvt_pk_bf16(o[6], o[7]);
        *(LAS u32x4*)(Vs + row * 272 + ch * 16) = w; }
    __syncthreads();
    const int w8 = F.wave, t = 16 * w8 + fr;
    f32x4 acc[8];
#pragma unroll
    for (int i = 0; i < 8; ++i) acc[i] = (f32x4){0.f, 0.f, 0.f, 0.f};
    const int q4 = (F.lane >> 2) & 3, p4 = F.lane & 3;
    for (int ks = 0; ks <= (w8 >> 1); ++ks) {
        const float* wp = F.gm_ws + (size_t)(grp * 128 + t) * 128 + 32 * ks + 8 * fq; const f32x4 w0 = *(const f32x4*)wp, w1 = *(const f32x4*)(wp + 4); const int s0 = 32 * ks + 8 * fq;
        u32x4 bw; bw.x = cvt_pk_bf16(s0 + 0 <= t ? w0[0] : 0.f, s0 + 1 <= t ? w0[1] : 0.f); bw.y = cvt_pk_bf16(s0 + 2 <= t ? w0[2] : 0.f, s0 + 3 <= t ? w0[3] : 0.f);
        bw.z = cvt_pk_bf16(s0 + 4 <= t ? w1[0] : 0.f, s0 + 5 <= t ? w1[1] : 0.f); bw.w = cvt_pk_bf16(s0 + 6 <= t ? w1[2] : 0.f, s0 + 7 <= t ? w1[3] : 0.f);
        const LAS unsigned char* vb = Vs + (32 * ks + 8 * fq + q4) * 272 + 8 * p4;
#pragma unroll
        for (int dt = 0; dt < 8; ++dt) { const bf16x8 a = cat4(tr_read(vb + 32 * dt), tr_read(vb + 4 * 272 + 32 * dt)); acc[dt] = __builtin_amdgcn_mfma_f32_16x16x32_bf16(a, as_bf16x8(bw), acc[dt], 0, 0, 0); }
    }
    const float bias = F.gm_bs[grp * 128 + t]; bf16_t* up = F.UO + (size_t)(rowbase + t) * UOLD + colbase + 4 * fq;
#pragma unroll
    for (int dt = 0; dt < 8; ++dt) { const u32x2 uu = *(const u32x2*)(up + 16 * dt); u32x2 w;
        w.x = cvt_pk_bf16(bf_lo(uu.x) * (acc[dt][0] + bias), bf_hi(uu.x) * (acc[dt][1] + bias)); w.y = cvt_pk_bf16(bf_lo(uu.y) * (acc[dt][2] + bias), bf_hi(uu.y) * (acc[dt][3] + bias)); *(u32x2*)(up + 16 * dt) = w; }
    __syncthreads();
}
__device__ __forceinline__ void gmlp_sample_item(Frame& F, int item) {
    const int bs = item >> 7, cc = item & 127, c0 = 8 * cc, grp = c0 >> 7, r0 = MP + 8 * bs;
    float vn[8][8];
#pragma unroll
    for (int s = 0; s < 8; ++s) { const u32x4 raw = *(const u32x4*)(F.V + (size_t)(r0 + s) * D + c0); float mu, rstd; ln_stats(F.VSTAT, r0 + s, mu, rstd); ln8(raw, mu, rstd, F.gm_ln_g + c0, F.gm_ln_b + c0, vn[s]);
        float* gp = F.gv_sample + (size_t)(8 * bs + s) * D + c0; *(f32x4*)gp = (f32x4){vn[s][0], vn[s][1], vn[s][2], vn[s][3]}; *(f32x4*)(gp + 4) = (f32x4){vn[s][4], vn[s][5], vn[s][6], vn[s][7]}; }
#pragma unroll
    for (int t = 0; t < 8; ++t) {
        const float* wp = F.gm_ws + (size_t)(grp * 128 + t) * 128; const float bias = F.gm_bs[grp * 128 + t]; float mix[8];
#pragma unroll
        for (int c = 0; c < 8; ++c) mix[c] = bias;
#pragma unroll
        for (int s = 0; s < 8; ++s) if (s <= t) { const float ww = wp[s];
#pragma unroll
            for (int c = 0; c < 8; ++c) mix[c] = fmaf(ww, vn[s][c], mix[c]); }
        bf16_t* up = F.UO + (size_t)(r0 + t) * UOLD + c0; const u32x4 uu = *(const u32x4*)up; u32x4 w;
        w.x = cvt_pk_bf16(bf_lo(uu.x) * mix[0], bf_hi(uu.x) * mix[1]); w.y = cvt_pk_bf16(bf_lo(uu.y) * mix[2], bf_hi(uu.y) * mix[3]); w.z = cvt_pk_bf16(bf_lo(uu.z) * mix[4], bf_hi(uu.z) * mix[5]); w.w = cvt_pk_bf16(bf_lo(uu.w) * mix[6], bf_hi(uu.w) * mix[7]);
        *(u32x4*)up = w;
    }
}
__device__ __forceinline__ void chain_item(Frame& F, int id) {
    const int bh = id >> 2, es = id & 3, b = bh >> 3, h = bh & 7, e0 = 64 * es;
    const float lg2 = __builtin_log2f(1.0f - __builtin_exp2f(-5.0f - (float)h)); const float g128 = __builtin_exp2f(128.f * lg2);
    const int fr = F.lane & 15, fq = F.lane >> 4, q4 = (F.lane >> 2) & 3, p4 = F.lane & 3, w8 = F.wave;
    constexpr int KSB = 128 * 272, VSB = 128 * 144;
    LAS unsigned char* Ks = F.lds; LAS unsigned char* Vs = F.lds + 2 * KSB;
    u32x4 kr[4], vr[2];
    const bf16_t* kg = F.K + (size_t)(b * 2048) * D + h * 128; const bf16_t* vg = F.RV + (size_t)(b * 2048) * 2048 + h * 256 + e0;
#define CH_LOAD(n) do { _Pragma("unroll") for (int i = 0; i < 4; ++i) { const int piece = F.tid + 512 * i; kr[i] = *(const u32x4*)(kg + (size_t)(128 * (n) + (piece >> 4)) * D + 8 * (piece & 15)); } \
        _Pragma("unroll") for (int i = 0; i < 2; ++i) { const int piece = F.tid + 512 * i; vr[i] = *(const u32x4*)(vg + (size_t)(128 * (n) + (piece >> 3)) * 2048 + 8 * (piece & 7)); } } while (0)
    f32x4 acc[4];
#pragma unroll
    for (int i = 0; i < 4; ++i) acc[i] = (f32x4){0.f, 0.f, 0.f, 0.f};
    CH_LOAD(0);
    for (int n = 0; n < 16; ++n) {
        const int buf = n & 1;
#pragma unroll
        for (int i = 0; i < 4; ++i) { const int piece = F.tid + 512 * i, row = piece >> 4, ch = piece & 15; const float dec = __builtin_exp2f((float)(127 - row) * lg2); u32x4 w;
            w.x = cvt_pk_bf16(bf_lo(kr[i].x) * dec, bf_hi(kr[i].x) * dec); w.y = cvt_pk_bf16(bf_lo(kr[i].y) * dec, bf_hi(kr[i].y) * dec); w.z = cvt_pk_bf16(bf_lo(kr[i].z) * dec, bf_hi(kr[i].z) * dec); w.w = cvt_pk_bf16(bf_lo(kr[i].w) * dec, bf_hi(kr[i].w) * dec);
            *(LAS u32x4*)(Ks + buf * KSB + row * 272 + ch * 16) = w; }
#pragma unroll
        for (int i = 0; i < 2; ++i) { const int piece = F.tid + 512 * i, row = piece >> 3, ch = piece & 7; *(LAS u32x4*)(Vs + buf * VSB + row * 144 + ch * 16) = vr[i]; }
        if (n < 15) CH_LOAD(n + 1);
        __syncthreads();
        bf16_t* sp = F.ST + ((size_t)(bh * 16 + n) * 256 + e0 + fr) * 128 + 16 * w8 + 4 * fq;
#pragma unroll
        for (int et = 0; et < 4; ++et) { u32x2 w; w.x = cvt_pk_bf16(acc[et][0], acc[et][1]); w.y = cvt_pk_bf16(acc[et][2], acc[et][3]); *(u32x2*)(sp + (size_t)(16 * et) * 128) = w; acc[et] *= g128; }
#pragma unroll
        for (int ks = 0; ks < 4; ++ks) {
            const int l0 = 32 * ks + 8 * fq + q4;
            const LAS unsigned char* ka = Ks + buf * KSB + l0 * 272 + (16 * w8 + 4 * p4) * 2; const bf16x8 a = cat4(tr_read(ka), tr_read(ka + 4 * 272));
            const LAS unsigned char* va = Vs + buf * VSB + l0 * 144 + 8 * p4;
#pragma unroll
            for (int et = 0; et < 4; ++et) { const bf16x8 bb = cat4(tr_read(va + 32 * et), tr_read(va + 4 * 144 + 32 * et)); acc[et] = __builtin_amdgcn_mfma_f32_16x16x32_bf16(a, bb, acc[et], 0, 0, 0); }
        }
    }
#undef CH_LOAD
#pragma unroll
    for (int et = 0; et < 4; ++et)
#pragma unroll
        for (int r = 0; r < 4; ++r) F.rs_prompt[((size_t)bh * 128 + dorig_of(16 * w8 + 4 * fq + r)) * 256 + e0 + 16 * et + fr] = acc[et][r];
    __syncthreads();
}
__device__ __forceinline__ void retout_item(Frame& F, int item) {
    const int n = item & 15, bh = item >> 4, b = bh >> 3, h = bh & 7, rowbase = b * 2048 + 128 * n;
    const float lg2 = __builtin_log2f(1.0f - __builtin_exp2f(-5.0f - (float)h));
    const int fr = F.lane & 15, fq = F.lane >> 4, q4 = (F.lane >> 2) & 3, p4 = F.lane & 3, w8 = F.wave;
    LAS unsigned char* STs = F.lds; LAS unsigned char* Vs = F.lds + 256 * 272;
    { const bf16_t* sg = F.ST + (size_t)(bh * 16 + n) * 256 * 128;
#pragma unroll
      for (int i = 0; i < 8; ++i) { const int piece = F.tid + 512 * i, row = piece >> 4, ch = piece & 15; *(LAS u32x4*)(STs + row * 272 + ch * 16) = *(const u32x4*)(sg + (size_t)row * 128 + 8 * ch); }
      const bf16_t* vg = F.RV + (size_t)rowbase * 2048 + h * 256;
#pragma unroll
      for (int i = 0; i < 8; ++i) { const int piece = F.tid + 512 * i, row = piece >> 5, ch = piece & 31; *(LAS u32x4*)(Vs + row * 528 + ch * 16) = *(const u32x4*)(vg + (size_t)row * 2048 + 8 * ch); } }
    const int l = 16 * w8 + fr;
    bf16x8 qf[4];
#pragma unroll
    for (int ks = 0; ks < 4; ++ks) qf[ks] = *(const bf16x8*)(F.Q + (size_t)(rowbase + l) * D + h * 128 + 32 * ks + 8 * fq);
    __syncthreads();
    f32x4 acc[16];
#pragma unroll
    for (int i = 0; i < 16; ++i) acc[i] = (f32x4){0.f, 0.f, 0.f, 0.f};
#pragma unroll
    for (int ks = 0; ks < 4; ++ks)
#pragma unroll
        for (int et = 0; et < 16; ++et) { const bf16x8 a = *(const LAS bf16x8*)(STs + (16 * et + fr) * 272 + (32 * ks + 8 * fq) * 2); acc[et] = __builtin_amdgcn_mfma_f32_16x16x32_bf16(a, qf[ks], acc[et], 0, 0, 0); }
    { const float f = __builtin_exp2f((float)(l + 1) * lg2);
#pragma unroll
      for (int et = 0; et < 16; ++et) acc[et] *= f; }
    const bf16_t* kg = F.K + (size_t)rowbase * D + h * 128 + 8 * fq;
    for (int k2 = 0; k2 <= (w8 >> 1); ++k2) {
        f32x4 s0 = (f32x4){0.f, 0.f, 0.f, 0.f}, s1 = (f32x4){0.f, 0.f, 0.f, 0.f};
#pragma unroll
        for (int ks = 0; ks < 4; ++ks) { const bf16x8 a0 = *(const bf16x8*)(kg + (size_t)(32 * k2 + fr) * D + 32 * ks), a1 = *(const bf16x8*)(kg + (size_t)(32 * k2 + 16 + fr) * D + 32 * ks);
            s0 = __builtin_amdgcn_mfma_f32_16x16x32_bf16(a0, qf[ks], s0, 0, 0, 0); s1 = __builtin_amdgcn_mfma_f32_16x16x32_bf16(a1, qf[ks], s1, 0, 0, 0); }
        float p[8];
#pragma unroll
        for (int r = 0; r < 4; ++r) { const int sa = 32 * k2 + 4 * fq + r, sb = sa + 16; p[r] = sa <= l ? s0[r] * __builtin_exp2f((float)(l - sa) * lg2) : 0.f; p[4 + r] = sb <= l ? s1[r] * __builtin_exp2f((float)(l - sb) * lg2) : 0.f; }
        u32x4 pw; pw.x = cvt_pk_bf16(p[0], p[1]); pw.y = cvt_pk_bf16(p[2], p[3]); pw.z = cvt_pk_bf16(p[4], p[5]); pw.w = cvt_pk_bf16(p[6], p[7]);
        const LAS unsigned char* va = Vs + (32 * k2 + 4 * fq + q4) * 528 + 8 * p4;
#pragma unroll
        for (int et = 0; et < 16; ++et) { const bf16x8 a = cat4(tr_read(va + 32 * et), tr_read(va + 16 * 528 + 32 * et)); acc[et] = __builtin_amdgcn_mfma_f32_16x16x32_bf16(a, as_bf16x8(pw), acc[et], 0, 0, 0); }
    }
    float ss = 0.f;
#pragma unroll
    for (int et = 0; et < 16; ++et) ss += (acc[et][0] * acc[et][0] + acc[et][1] * acc[et][1]) + (acc[et][2] * acc[et][2] + acc[et][3] * acc[et][3]);
    ss += __shfl_xor(ss, 16); ss += __shfl_xor(ss, 32);
    const float rstd = 1.0f / sqrtf(ss * (1.f / 256.f) + EPS);
    bf16_t* op = F.UO + (size_t)(rowbase + l) * UOLD + 1024 + h * 256 + 4 * fq;
#pragma unroll
    for (int et = 0; et < 16; ++et) { const u32x2 g = *(const u32x2*)(op + 16 * et); u32x2 w; w.x = cvt_pk_bf16(acc[et][0] * rstd * bf_lo(g.x), acc[et][1] * rstd * bf_hi(g.x)); w.y = cvt_pk_bf16(acc[et][2] * rstd * bf_lo(g.y), acc[et][3] * rstd * bf_hi(g.y)); *(u32x2*)(op + 16 * et) = w; }
    __syncthreads();
}
__device__ __forceinline__ void retsample_item(Frame& F, int item) {
    const int bs = item >> 3, h = item & 7, r0 = MP + 8 * bs;
    const float lg2 = __builtin_log2f(1.0f - __builtin_exp2f(-5.0f - (float)h)); const float g8 = __builtin_exp2f(8.f * lg2);
    LAS float* qsT = (LAS float*)F.lds;
    LAS float* ksT = qsT + 1024;
    LAS float* vs = ksT + 1024;
    LAS float* Pm = vs + 2048;
    LAS float* part = Pm + 64;
    LAS float* red = part + 2048;
    const int t = F.tid;
    { const int row = t >> 6, cp = t & 63; const unsigned qw = *(const unsigned*)(F.Q + (size_t)(r0 + row) * D + h * 128 + 2 * cp), kw = *(const unsigned*)(F.K + (size_t)(r0 + row) * D + h * 128 + 2 * cp);
      const float dec = __builtin_exp2f((float)(7 - row) * lg2);
      qsT[(2 * cp) * 8 + row] = bf_lo(qw); qsT[(2 * cp + 1) * 8 + row] = bf_hi(qw); ksT[(2 * cp) * 8 + row] = bf_lo(kw) * dec; ksT[(2 * cp + 1) * 8 + row] = bf_hi(kw) * dec;
      const u32x2 vw = *(const u32x2*)(F.RV + (size_t)(r0 + row) * 2048 + h * 256 + 4 * cp); *(LAS f32x4*)(vs + row * 256 + 4 * cp) = (f32x4){bf_lo(vw.x), bf_hi(vw.x), bf_lo(vw.y), bf_hi(vw.y)}; }
    __syncthreads();
    if (t < 64) { const int l = t >> 3, s = t & 7; float d = 0.f; if (s <= l) { for (int p = 0; p < 128; ++p) d = fmaf(qsT[p * 8 + l], ksT[p * 8 + s], d); d *= __builtin_exp2f((float)(l - 7) * lg2); } Pm[t] = d; }
    const int e = t & 255, half = t >> 8;
    float vreg[8], inter[8];
#pragma unroll
    for (int l = 0; l < 8; ++l) { vreg[l] = vs[l * 256 + e]; inter[l] = 0.f; }
    const size_t sbase = (size_t)(bs * 8 + h) * 128 * 256 + e;
#pragma unroll 4
    for (int pp = 0; pp < 64; ++pp) {
        const int p = 64 * half + pp, d = dorig_of(p); const float s0 = F.state_ret[sbase + (size_t)d * 256];
        const f32x4 qa = *(const LAS f32x4*)(qsT + p * 8), qb = *(const LAS f32x4*)(qsT + p * 8 + 4), ka = *(const LAS f32x4*)(ksT + p * 8), kb = *(const LAS f32x4*)(ksT + p * 8 + 4);
        float sn = g8 * s0;
#pragma unroll
        for (int l = 0; l < 4; ++l) { inter[l] = fmaf(qa[l], s0, inter[l]); inter[4 + l] = fmaf(qb[l], s0, inter[4 + l]); sn = fmaf(ka[l], vreg[l], sn); sn = fmaf(kb[l], vreg[4 + l], sn); }
        F.rs_sample[sbase + (size_t)d * 256] = sn;
    }
    __syncthreads();
    if (half == 1) {
#pragma unroll
        for (int l = 0; l < 8; ++l) part[l * 256 + e] = inter[l]; }
    __syncthreads();
    float o[8];
    if (half == 0) {
#pragma unroll
        for (int l = 0; l < 8; ++l) { float a = (inter[l] + part[l * 256 + e]) * __builtin_exp2f((float)(l + 1) * lg2);
#pragma unroll
            for (int s = 0; s < 8; ++s) if (s <= l) a = fmaf(Pm[l * 8 + s], vreg[s], a);
            o[l] = a; const float sq = wave_sum(a * a); if (F.lane == 0) red[l * 4 + F.wave] = sq; }
    }
    __syncthreads();
    if (half == 0) {
#pragma unroll
        for (int l = 0; l < 8; ++l) { const float ss = (red[l * 4] + red[l * 4 + 1]) + (red[l * 4 + 2] + red[l * 4 + 3]); const float rstd = 1.0f / sqrtf(ss * (1.f / 256.f) + EPS);
            bf16_t* op = F.UO + (size_t)(r0 + l) * UOLD + 1024 + h * 256 + e; const float g = __uint_as_float((unsigned)(*op) << 16); *op = (bf16_t)(cvt_pk_bf16(o[l] * rstd * g, 0.f) & 0xffffu); }
    }
    __syncthreads();
}

__global__ void __launch_bounds__(512, 2) mega_fwd(Args args) {
    extern __shared__ __attribute__((aligned(16))) unsigned char lds[];
    Frame F;
    F.lds = (LAS unsigned char*)lds;
    volatile LAS unsigned* MISC = (volatile LAS unsigned*)(F.lds + MISC_OFF);
    F.tid = threadIdx.x; F.lane = F.tid & 63; F.wave = __builtin_amdgcn_readfirstlane(F.tid >> 6);
    F.G = gridDim.x; { const int bx = blockIdx.x; F.vcu = (F.G % 8 == 0) ? (bx % 8) * (F.G / 8) + bx / 8 : bx; }
    unsigned char* ws = args.ws; unsigned* ctl = (unsigned*)(ws + WS_CTL);
    F.x_prompt = args.in[0]; F.x_sample = args.in[1]; F.state_ret = args.in[2]; F.c_prompt = args.in[3]; F.c_sample = args.in[4]; F.w_ada = args.in[5]; F.b_ada = args.in[6]; F.n1_g = args.in[7];
    F.w1_gate = args.in[8]; F.w1_up = args.in[9]; F.w1_down = args.in[10]; F.nm_g = args.in[11]; F.w_in = args.in[12]; F.gm_ln_g = args.in[13]; F.gm_ln_b = args.in[14]; F.gm_ws = args.in[15]; F.gm_bs = args.in[16];
    F.w_a = args.in[17]; F.w_b = args.in[18]; F.w_o = args.in[19]; F.n2_g = args.in[20]; F.w2_gate = args.in[21]; F.w2_up = args.in[22]; F.w2_down = args.in[23]; F.final_g = args.in[24];
    F.X = args.out; F.rs_prompt = args.out + (size_t)MT * D; F.rs_sample = F.rs_prompt + (size_t)64 * 128 * 256; F.gv_sample = F.rs_sample + (size_t)1024 * 128 * 256;
    F.MOD = (float*)(ws + WS_MOD); F.ROPEC = (float*)(ws + WS_ROPEC); F.ROPES = (float*)(ws + WS_ROPES); F.VSTAT = (unsigned long long*)(ctl + CW_VSTAT);
    F.W1GU = (bf16_t*)(ws + WS_W1GU); F.W1D = (bf16_t*)(ws + WS_W1D); F.W2GU = (bf16_t*)(ws + WS_W2GU); F.W2D = (bf16_t*)(ws + WS_W2D); F.WIN = (bf16_t*)(ws + WS_WIN); F.WAB = (bf16_t*)(ws + WS_WAB); F.WO = (bf16_t*)(ws + WS_WO);
    F.H = (bf16_t*)(ws + WS_H); F.UO = (bf16_t*)(ws + WS_UO); F.V = (bf16_t*)(ws + WS_V); F.Q = (bf16_t*)(ws + WS_Q); F.K = (bf16_t*)(ws + WS_K); F.RV = (bf16_t*)(ws + WS_RV); F.SGA = (bf16_t*)(ws + WS_SGA); F.SGB = (bf16_t*)(ws + WS_SGB);
    F.HID = (bf16_t*)(ws + WS_HID); F.ST = (bf16_t*)(ws + WS_ST);
    if (F.tid < 128) MISC[F.tid] = 0u;
    __syncthreads();
    const int lo = args.ph_lo, hi = args.ph_hi;
    XcdBarrier bar; bar.bar = ctl + CW_BAR; bar.x = 0; bar.st = nullptr;
    if (hi - lo > 1) bar = xcd_barrier_post(ctl + CW_BAR, MISC + 8);
#ifndef PHMASK
#define PHMASK 0x3fff
#endif
#define IN(k) (((PHMASK >> (k)) & 1) && lo <= (k) && (k) < hi)
#define SEAM(k) do { if (IN(k) && IN((k) + 1)) xcd_barrier(bar); } while (0)

    if (IN(0)) { p0_prologue(F); } SEAM(0);
    if (IN(1)) { norm_mod_phase(F, F.x_prompt, F.x_sample, F.n1_g, 0 * D, 1 * D); } SEAM(1);
    if (IN(2)) { pg8::Gemm g{F.H, F.W1GU, MT, NGU, D}; pg8::StaticOrder S; S.init(MT, NGU, F.G, (int)blockIdx.x); EpiGateUp E{F.HID}; pg8::gemm_phase(F.lds, g, S, E); } SEAM(2);
    if (IN(3)) { pg8::Gemm g{F.HID, F.W1D, MT, D, DFF}; pg8::StaticOrder S; S.init(MT, D, F.G, (int)blockIdx.x); EpiResid E{F.x_prompt, F.x_sample, F.X, F.MOD, 2 * D, 0.5f}; pg8::gemm_phase(F.lds, g, S, E); } SEAM(3);
    if (IN(4)) { norm_mod_phase(F, F.X, F.X + (size_t)MP * D, F.nm_g, 3 * D, 4 * D); } SEAM(4);
    if (IN(5)) { pg8::Gemm g{F.H, F.WIN, MT, NIN, D}; pg8::StaticOrder S; S.init(MT, NIN, F.G, (int)blockIdx.x); EpiWin E{F.UO, F.V, F.Q, F.K, F.RV, F.SGA, F.SGB, F.VSTAT, F.ROPEC, F.ROPES}; pg8::gemm_phase(F.lds, g, S, E); } SEAM(5);
    if (IN(6)) {
        for (int id = F.vcu; id < 256; id += F.G) chain_item(F, id);
        for (int tile = F.vcu; tile < 1024; tile += F.G) gmlp_tile(F, tile);
        for (int it = F.vcu + F.G * F.tid; it < 128 * 128; it += F.G * 512) gmlp_sample_item(F, it);
        for (int it = F.vcu; it < 512; it += F.G) retsample_item(F, it);
    } SEAM(6);
    if (IN(7)) {
        for (int it = F.vcu; it < 1024; it += F.G) retout_item(F, it);
        for (int it = 512 + F.vcu; it < 1024; it += F.G) retsample_item(F, it);
    } SEAM(7);
    if (IN(8)) { pg8::Gemm g{F.UO, F.WAB, MT, D, 3072}; pg8::StaticOrder S; S.init(MT, D, F.G, (int)blockIdx.x); EpiMerged E{F.SGA, F.SGB, F.H}; pg8::gemm_phase(F.lds, g, S, E); } SEAM(8);
    if (IN(9)) { pg8::Gemm g{F.H, F.WO, MT, D, D}; pg8::StaticOrder S; S.init(MT, D, F.G, (int)blockIdx.x); EpiResid E{F.X, F.X + (size_t)MP * D, F.X, F.MOD, 5 * D, 1.0f}; pg8::gemm_phase(F.lds, g, S, E); } SEAM(9);
    if (IN(10)) { norm_mod_phase(F, F.X, F.X + (size_t)MP * D, F.n2_g, 6 * D, 7 * D); } SEAM(10);
    if (IN(11)) { pg8::Gemm g{F.H, F.W2GU, MT, NGU, D}; pg8::StaticOrder S; S.init(MT, NGU, F.G, (int)blockIdx.x); EpiGateUp E{F.HID}; pg8::gemm_phase(F.lds, g, S, E); } SEAM(11);
    if (IN(12)) { pg8::Gemm g{F.HID, F.W2D, MT, D, DFF}; pg8::StaticOrder S; S.init(MT, D, F.G, (int)blockIdx.x); EpiResid E{F.X, F.X + (size_t)MP * D, F.X, F.MOD, 8 * D, 0.5f}; pg8::gemm_phase(F.lds, g, S, E); } SEAM(12);
    if (IN(13)) { final_norm_phase(F); }
#undef IN
#undef SEAM
}

#ifdef DBG_LAST
__global__ void dbg_dump_bf16(const bf16_t* src, float* dst, size_t n) { for (size_t i = (size_t)blockIdx.x * 256 + threadIdx.x; i < n; i += (size_t)gridDim.x * 256) dst[i] = __uint_as_float((unsigned)src[i] << 16); }
__global__ void dbg_dump_f32(const float* src, float* dst, size_t n) { for (size_t i = (size_t)blockIdx.x * 256 + threadIdx.x; i < n; i += (size_t)gridDim.x * 256) dst[i] = src[i]; }
__global__ void dbg_fill(float* dst, size_t n) { for (size_t i = (size_t)blockIdx.x * 256 + threadIdx.x; i < n; i += (size_t)gridDim.x * 256) dst[i] = 1.0f; }
#endif
#ifdef DBG_CK
__global__ void dbg_cksum(const unsigned* p, size_t nwords, unsigned long long* out) {
    unsigned long long s = 0; for (size_t i = (size_t)blockIdx.x * 256 + threadIdx.x; i < nwords; i += (size_t)gridDim.x * 256) s += (unsigned long long)p[i] * ((i & 0xffffu) + 1u);
    for (int o = 32; o > 0; o >>= 1) s += __shfl_xor(s, o);
    if ((threadIdx.x & 63) == 0) atomicAdd(out, s);
}
__global__ void dbg_encode(const unsigned long long* ck, float* ys, size_t n, int nph) {
    int bad = -1; for (int p = 0; p < nph && bad < 0; ++p) for (int r = 1; r < DBG_CK; ++r) if (ck[p] != ck[16 * r + p]) { bad = p; break; }
    if (bad < 0) return;
    const float f = 1.0f + sqrtf((float)(bad + 1));
    for (size_t i = (size_t)blockIdx.x * 256 + threadIdx.x; i < n; i += (size_t)gridDim.x * 256) ys[i] *= f;
}
#endif
#if defined(DBG_MIX) || defined(DBG_HYB) || defined(DBG_SUB) || defined(DBG_PTR)
#include <math.h>
__global__ void dbg_cvt(const bf16_t* src, int ld, int coff, float* dst, int R, int W) { for (size_t i = (size_t)blockIdx.x * 256 + threadIdx.x; i < (size_t)R * W; i += (size_t)gridDim.x * 256) { const int r = (int)(i / W), c = (int)(i % W); dst[i] = __uint_as_float((unsigned)src[(size_t)r * ld + coff + c] << 16); } }
__global__ void dbg_cvt_perm(const bf16_t* src, float* dst, int R) { for (size_t i = (size_t)blockIdx.x * 256 + threadIdx.x; i < (size_t)R * 1024; i += (size_t)gridDim.x * 256) { const int r = (int)(i >> 10), c = (int)(i & 1023), h = c >> 7, p = c & 127; dst[(size_t)r * 1024 + h * 128 + dorig_of(p)] = __uint_as_float((unsigned)src[i] << 16); } }
__global__ void dbg_mul_cvt(const bf16_t* src, int ld, int coff, float* dst, int R, int W) { for (size_t i = (size_t)blockIdx.x * 256 + threadIdx.x; i < (size_t)R * W; i += (size_t)gridDim.x * 256) { const int r = (int)(i / W), c = (int)(i % W); dst[i] *= __uint_as_float((unsigned)src[(size_t)r * ld + coff + c] << 16); } }
__global__ void dbg_maxdiff(const float* a, const bf16_t* b, size_t n, unsigned* out) { float m = 0.f; for (size_t i = (size_t)blockIdx.x * 256 + threadIdx.x; i < n; i += (size_t)gridDim.x * 256) m = fmaxf(m, fabsf(a[i] - __uint_as_float((unsigned)b[i] << 16)));
    for (int o = 32; o > 0; o >>= 1) m = fmaxf(m, __shfl_xor(m, o)); if ((threadIdx.x & 63) == 0) atomicMax(out, __float_as_uint(m)); }
#ifndef DBG_DIFF
#define DBG_DIFF 0
#endif
__global__ void dbg_fracbad(const bf16_t* b, size_t n, unsigned* cnt) { unsigned c = 0; for (size_t i = (size_t)blockIdx.x * 256 + threadIdx.x; i < n; i += (size_t)gridDim.x * 256) { const float v = __uint_as_float((unsigned)b[i] << 16); c += (DBG_DIFF == 5 ? (fabsf(v) > 2.f) : (v < 0.f || v > 1.001f)) ? 1u : 0u; } atomicAdd(cnt, c); }
__global__ void dbg_frac2code(unsigned* code, size_t n) { const float f = (float)code[1] / (float)n; code[0] = __float_as_uint(f); }
__global__ void dbg_scale_imm(float* y, size_t n, float f) { for (size_t i = (size_t)blockIdx.x * 256 + threadIdx.x; i < n; i += (size_t)gridDim.x * 256) y[i] *= f; }
__global__ void dbg_scale(float* y, size_t n, const unsigned* code) { const float f = 1.0f + __uint_as_float(*code); for (size_t i = (size_t)blockIdx.x * 256 + threadIdx.x; i < n; i += (size_t)gridDim.x * 256) y[i] *= f; }
__global__ void dbg_copy(const float* src, float* dst, size_t n) { for (size_t i = (size_t)blockIdx.x * 256 + threadIdx.x; i < n; i += (size_t)gridDim.x * 256) dst[i] = src[i]; }
namespace nv {
constexpr int D = 1024, DFF = 2816, NSEQ = 136, NMOD = 9216;
constexpr int MP = 16384, MS = 1024;

__device__ __forceinline__ float silu_f(float x) { return x / (1.f + expf(-x)); }
__device__ __forceinline__ float sigm_f(float x) { return 1.f / (1.f + expf(-x)); }
__device__ __forceinline__ float gelu_f(float x) { const float u = 0.7978845608028654f * (x + 0.044715f * x * x * x); return 0.5f * x * (1.f + tanhf(u)); }

struct GemmP { const float* A; const float* B; float* C; const float* aux; const float* aux2; int lda, ldb, ldc, M, N, K, rows_per_seq, seq0; float scale; int pad; };
template <int EPI>
__global__ void __launch_bounds__(256) gemm_naive(GemmP p) {
    __shared__ float As[16][65];
    __shared__ float Bs[16][64];
    const int tx = threadIdx.x & 15, ty = threadIdx.x >> 4;
    const int m0 = blockIdx.y * 64, n0 = blockIdx.x * 64;
    float acc[4][4];
#pragma unroll
    for (int i = 0; i < 4; ++i)
#pragma unroll
        for (int j = 0; j < 4; ++j) acc[i][j] = 0.f;
    for (int k0 = 0; k0 < p.K; k0 += 16) {
#pragma unroll
        for (int i = 0; i < 4; ++i) { const int e = threadIdx.x + i * 256; const int r = e >> 4, c = e & 15; int gr = m0 + r; if (gr >= p.M) gr = p.M - 1; As[c][r] = p.A[(size_t)gr * p.lda + k0 + c]; }
#pragma unroll
        for (int i = 0; i < 4; ++i) { const int e = threadIdx.x + i * 256; const int r = e >> 6, c = e & 63; Bs[r][c] = p.B[(size_t)(k0 + r) * p.ldb + n0 + c]; }
        __syncthreads();
#pragma unroll
        for (int kk = 0; kk < 16; ++kk) {
            float a[4], b[4];
#pragma unroll
            for (int i = 0; i < 4; ++i) a[i] = As[kk][ty * 4 + i];
#pragma unroll
            for (int j = 0; j < 4; ++j) b[j] = Bs[kk][tx * 4 + j];
#pragma unroll
            for (int i = 0; i < 4; ++i)
#pragma unroll
                for (int j = 0; j < 4; ++j) acc[i][j] = fmaf(a[i], b[j], acc[i][j]);
        }
        __syncthreads();
    }
#pragma unroll
    for (int i = 0; i < 4; ++i) {
        const int r = m0 + ty * 4 + i; if (r >= p.M) continue;
#pragma unroll
        for (int j = 0; j < 4; ++j) {
            const int c = n0 + tx * 4 + j; float* cp = p.C + (size_t)r * p.ldc + c; const float a = acc[i][j]; float o;
            if (EPI == 0) o = a;
            else if (EPI == 1) o = a + p.aux[c];
            else if (EPI == 2) o = gelu_f(a);
            else if (EPI == 3) o = sigm_f(a);
            else if (EPI == 4) o = silu_f(*cp) * a;
            else if (EPI == 5) o = (*cp) * silu_f(a);
            else if (EPI == 6) o = (*cp) * a;
            else if (EPI == 7) o = p.aux[(size_t)r * p.ldc + c] + (*cp) * a;
            else { const int seq = p.seq0 + r / p.rows_per_seq; o = p.aux[(size_t)r * p.ldc + c] + p.scale * p.aux2[(size_t)seq * NMOD + c] * a; }
            *cp = o;
        }
    }
}

__global__ void silu_rows(const float* cp, const float* cs, float* out) {
    const int i = blockIdx.x * 256 + threadIdx.x; if (i >= NSEQ * D) return;
    const int s = i / D, c = i % D; const float v = s < 8 ? cp[s * D + c] : cs[(s - 8) * D + c]; out[i] = silu_f(v);
}
__device__ __forceinline__ float block_sum(float v, float* red) {
#pragma unroll
    for (int o = 32; o > 0; o >>= 1) v += __shfl_xor(v, o);
    __syncthreads();
    if ((threadIdx.x & 63) == 0) red[threadIdx.x >> 6] = v;
    __syncthreads();
    return red[0] + red[1] + red[2] + red[3];
}
__global__ void __launch_bounds__(256) norm_mod(const float* x, const float* g, const float* mod, int sh_off, int sc_off, int rows_per_seq, int seq0, float* out) {
    __shared__ float red[4];
    const int r = blockIdx.x; const float4 v = ((const float4*)(x + (size_t)r * D))[threadIdx.x];
    const float ss = block_sum(v.x * v.x + v.y * v.y + v.z * v.z + v.w * v.w, red);
    const float rstd = 1.0f / sqrtf(ss * (1.f / D) + 1e-6f);
    const float4 gg = ((const float4*)g)[threadIdx.x];
    float4 o = make_float4(v.x * rstd * gg.x, v.y * rstd * gg.y, v.z * rstd * gg.z, v.w * rstd * gg.w);
    if (mod) { const int seq = seq0 + r / rows_per_seq; const float4 sh = ((const float4*)(mod + (size_t)seq * NMOD + sh_off))[threadIdx.x], sc = ((const float4*)(mod + (size_t)seq * NMOD + sc_off))[threadIdx.x];
        o.x = o.x * (1.f + sc.x) + sh.x; o.y = o.y * (1.f + sc.y) + sh.y; o.z = o.z * (1.f + sc.z) + sh.z; o.w = o.w * (1.f + sc.w) + sh.w; }
    ((float4*)(out + (size_t)r * D))[threadIdx.x] = o;
}
__global__ void __launch_bounds__(256) ln_rows(float* v, const float* g, const float* b, float* out2) {
    __shared__ float red[4];
    const int r = blockIdx.x; float4 x = ((float4*)(v + (size_t)r * D))[threadIdx.x];
    const float mu = block_sum(x.x + x.y + x.z + x.w, red) * (1.f / D);
    x.x -= mu; x.y -= mu; x.z -= mu; x.w -= mu;
    const float var = block_sum(x.x * x.x + x.y * x.y + x.z * x.z + x.w * x.w, red) * (1.f / D);
    const float rstd = 1.0f / sqrtf(var + 1e-6f);
    const float4 gg = ((const float4*)g)[threadIdx.x], bb = ((const float4*)b)[threadIdx.x];
    float4 o = make_float4(x.x * rstd * gg.x + bb.x, x.y * rstd * gg.y + bb.y, x.z * rstd * gg.z + bb.z, x.w * rstd * gg.w + bb.w);
    ((float4*)(v + (size_t)r * D))[threadIdx.x] = o;
    if (out2) ((float4*)(out2 + (size_t)r * D))[threadIdx.x] = o;
}
__global__ void rotary_qk(float* q, float* k, int R, int L, int pos0) {
    const int i = blockIdx.x * 256 + threadIdx.x; if (i >= R * 8 * 64) return;
    const int r = i / 512, h = (i / 64) & 7, j = i & 63;
    const double inv = pow(10000.0, -(double)j / 64.0); const double ang = (double)(pos0 + (r % L)) * inv;
    const float c = (float)cos(ang), s = (float)sin(ang);
    float* qp = q + (size_t)r * D + h * 128 + j; float* kp = k + (size_t)r * D + h * 128 + j;
    const float q1 = qp[0], q2 = qp[64]; qp[0] = q1 * c - q2 * s; qp[64] = q1 * s + q2 * c;
    const float k1 = kp[0], k2 = kp[64]; const float sc = 0.08838834764831845f; kp[0] = (k1 * c - k2 * s) * sc; kp[64] = (k1 * s + k2 * c) * sc;
}
__global__ void spatial_mix(float* u, const float* vn, const float* ws, const float* bs, int R, int lc) {
    const size_t i = (size_t)blockIdx.x * 256 + threadIdx.x; if (i >= (size_t)R * D) return;
    const int r = (int)(i / D), c = (int)(i % D), g = c >> 7, t = r % lc, r0 = r - t;
    float acc = bs[g * 128 + t];
    for (int s = 0; s <= t; ++s) acc = fmaf(ws[(g * 128 + t) * 128 + s], vn[(size_t)(r0 + s) * D + c], acc);
    u[i] *= acc;
}
__global__ void __launch_bounds__(256) retention_rec(const float* q, const float* k, const float* v, float* o, const float* S0, float* Sout, int L) {
    __shared__ float qs[8][128], ks[8][128];
    const int b = blockIdx.x >> 3, h = blockIdx.x & 7, e = threadIdx.x;
    const float gamma = 1.0f - exp2f(-5.0f - (float)h);
    float S[128];
#pragma unroll
    for (int d = 0; d < 128; ++d) S[d] = S0 ? S0[((size_t)(b * 8 + h) * 128 + d) * 256 + e] : 0.f;
    for (int t0 = 0; t0 < L; t0 += 8) {
        __syncthreads();
        for (int i = threadIdx.x; i < 8 * 128; i += 256) { const int tt = i >> 7, d = i & 127; const size_t off = (size_t)(b * L + t0 + tt) * D + h * 128 + d; qs[tt][d] = q[off]; ks[tt][d] = k[off]; }
        __syncthreads();
        for (int tt = 0; tt < 8; ++tt) {
            const size_t row = (size_t)(b * L + t0 + tt);
            const float vv = v[row * 2048 + h * 256 + e]; float acc = 0.f;
#pragma unroll
            for (int d = 0; d < 128; ++d) { S[d] = fmaf(ks[tt][d], vv, gamma * S[d]); acc = fmaf(qs[tt][d], S[d], acc); }
            o[row * 2048 + h * 256 + e] = acc;
        }
    }
#pragma unroll
    for (int d = 0; d < 128; ++d) Sout[((size_t)(b * 8 + h) * 128 + d) * 256 + e] = S[d];
}
__global__ void __launch_bounds__(256) head_rms(float* o, int R) {
    const int w = blockIdx.x * 4 + (threadIdx.x >> 6), lane = threadIdx.x & 63; if (w >= R * 8) return;
    float4* p = (float4*)(o + (size_t)w * 256) + lane; float4 x = *p; float s = x.x * x.x + x.y * x.y + x.z * x.z + x.w * x.w;
#pragma unroll
    for (int of = 32; of > 0; of >>= 1) s += __shfl_xor(s, of);
    const float r = 1.0f / sqrtf(s * (1.f / 256.f) + 1e-6f); x.x *= r; x.y *= r; x.z *= r; x.w *= r; *p = x;
}

template <int EPI> static void gemm(hipStream_t st, const float* A, int lda, const float* B, int ldb, float* C, int ldc, int M, int N, int K, const float* aux = nullptr, const float* aux2 = nullptr, int rps = 1, int seq0 = 0, float scale = 1.f) {
    GemmP p; memset(&p, 0, sizeof(p)); p.A = A; p.B = B; p.C = C; p.aux = aux; p.aux2 = aux2; p.lda = lda; p.ldb = ldb; p.ldc = ldc; p.M = M; p.N = N; p.K = K; p.rows_per_seq = rps; p.seq0 = seq0; p.scale = scale;
    hipLaunchKernelGGL(gemm_naive<EPI>, dim3(N / 64, (M + 63) / 64), dim3(256), 0, st, p);
}

static void forward(void* const* d_in, float* out, unsigned char* ws, hipStream_t st) {
    const float* x_prompt = (const float*)d_in[0]; const float* x_sample = (const float*)d_in[1]; const float* state_ret = (const float*)d_in[2];
    const float* c_prompt = (const float*)d_in[3]; const float* c_sample = (const float*)d_in[4]; const float* w_ada = (const float*)d_in[5]; const float* b_ada = (const float*)d_in[6];
    const float* n1_g = (const float*)d_in[7]; const float* w1_gate = (const float*)d_in[8]; const float* w1_up = (const float*)d_in[9]; const float* w1_down = (const float*)d_in[10];
    const float* nm_g = (const float*)d_in[11]; const float* w_in = (const float*)d_in[12]; const float* gm_ln_g = (const float*)d_in[13]; const float* gm_ln_b = (const float*)d_in[14];
    const float* gm_ws = (const float*)d_in[15]; const float* gm_bs = (const float*)d_in[16]; const float* w_a = (const float*)d_in[17]; const float* w_b = (const float*)d_in[18]; const float* w_o = (const float*)d_in[19];
    const float* n2_g = (const float*)d_in[20]; const float* w2_gate = (const float*)d_in[21]; const float* w2_up = (const float*)d_in[22]; const float* w2_down = (const float*)d_in[23]; const float* final_g = (const float*)d_in[24];
    float* y_prompt = out; float* y_sample = out + (size_t)MP * D; float* rs_prompt = y_sample + (size_t)MS * D; float* rs_sample = rs_prompt + (size_t)8 * 8 * 128 * 256; float* gv_sample = rs_sample + (size_t)128 * 8 * 128 * 256;
    constexpr int RG = 4096;
    size_t off = 0; auto carve = [&](size_t nfloats) { float* p = (float*)(ws + off); off += ((nfloats * 4 + 255) / 256) * 256; return p; };
    float* MOD = carve((size_t)NSEQ * NMOD); float* SC = carve((size_t)NSEQ * D);
    float* X = carve((size_t)RG * D); float* H = carve((size_t)RG * D); float* G = carve((size_t)RG * DFF);
    float* U = carve((size_t)RG * D); float* V = carve((size_t)RG * D); float* Q = carve((size_t)RG * D); float* K = carve((size_t)RG * D);
    float* RV = carve((size_t)RG * 2048); float* OR = carve((size_t)RG * 2048); float* GA = carve((size_t)RG * D); float* GB = carve((size_t)RG * D); float* MG = carve((size_t)RG * D);

    hipLaunchKernelGGL(silu_rows, dim3((NSEQ * D + 255) / 256), dim3(256), 0, st, c_prompt, c_sample, SC);
    gemm<1>(st, SC, D, w_ada, NMOD, MOD, NMOD, NSEQ, NMOD, D, b_ada);
    for (int grp = 0; grp < 5; ++grp) {
        const bool smp = grp == 4; const int R = smp ? MS : RG, L = smp ? 8 : 2048, lc = smp ? 8 : 128, seq0 = smp ? 8 : grp * 2, pos0 = smp ? 16384 : 0, nseq = R / L;
        const float* xin = smp ? x_sample : x_prompt + (size_t)grp * RG * D; float* yout = smp ? y_sample : y_prompt + (size_t)grp * RG * D;
        hipLaunchKernelGGL(norm_mod, dim3(R), dim3(256), 0, st, xin, n1_g, MOD, 0 * D, 1 * D, L, seq0, H);
        gemm<0>(st, H, D, w1_gate, DFF, G, DFF, R, DFF, D);
        gemm<4>(st, H, D, w1_up, DFF, G, DFF, R, DFF, D);
        gemm<8>(st, G, DFF, w1_down, D, X, D, R, D, DFF, xin, MOD + 2 * D, L, seq0, 0.5f);
        hipLaunchKernelGGL(norm_mod, dim3(R), dim3(256), 0, st, X, nm_g, MOD, 3 * D, 4 * D, L, seq0, H);
        gemm<2>(st, H, D, w_in + 0, 10240, U, D, R, D, D);
        gemm<2>(st, H, D, w_in + 1024, 10240, V, D, R, D, D);
        gemm<0>(st, H, D, w_in + 2048, 10240, Q, D, R, D, D);
        gemm<0>(st, H, D, w_in + 3072, 10240, K, D, R, D, D);
        gemm<0>(st, H, D, w_in + 4096, 10240, RV, 2048, R, 2048, D);
        gemm<3>(st, H, D, w_in + 8192, 10240, GA, D, R, D, D);
        gemm<3>(st, H, D, w_in + 9216, 10240, GB, D, R, D, D);
        hipLaunchKernelGGL(ln_rows, dim3(R), dim3(256), 0, st, V, gm_ln_g, gm_ln_b, smp ? gv_sample : (float*)nullptr);
        hipLaunchKernelGGL(spatial_mix, dim3((unsigned)(((size_t)R * D + 255) / 256)), dim3(256), 0, st, U, V, gm_ws, gm_bs, R, lc);
        hipLaunchKernelGGL(rotary_qk, dim3((R * 512 + 255) / 256), dim3(256), 0, st, Q, K, R, L, pos0);
        hipLaunchKernelGGL(retention_rec, dim3(nseq * 8), dim3(256), 0, st, Q, K, RV, OR, smp ? state_ret : (const float*)nullptr, smp ? rs_sample : rs_prompt + (size_t)grp * 2 * 8 * 128 * 256, L);
        hipLaunchKernelGGL(head_rms, dim3((R * 8 + 3) / 4), dim3(256), 0, st, OR, R);
        gemm<5>(st, H, D, w_in + 6144, 10240, OR, 2048, R, 2048, D);
        gemm<6>(st, U, D, w_a, D, GA, D, R, D, D);
        gemm<7>(st, OR, 2048, w_b, D, GB, D, R, D, 2048, GA);
        gemm<8>(st, GB, D, w_o, D, MG, D, R, D, D, X, MOD + 5 * D, L, seq0, 1.0f);
        hipLaunchKernelGGL(norm_mod, dim3(R), dim3(256), 0, st, MG, n2_g, MOD, 6 * D, 7 * D, L, seq0, H);
        gemm<0>(st, H, D, w2_gate, DFF, G, DFF, R, DFF, D);
        gemm<4>(st, H, D, w2_up, DFF, G, DFF, R, DFF, D);
        gemm<8>(st, G, DFF, w2_down, D, X, D, R, D, DFF, MG, MOD + 8 * D, L, seq0, 0.5f);
        hipLaunchKernelGGL(norm_mod, dim3(R), dim3(256), 0, st, X, final_g, (const float*)nullptr, 0, 0, L, seq0, yout);
    }
}
}


#endif
extern "C" void kernel_launch(void* const* d_in, const int* in_sizes, int n_in, void* d_out, int out_size, void* d_ws, size_t ws_size, hipStream_t stream) {
    static int grid = 0;
    if (grid == 0) {
        if (n_in != 25 || ws_size < WS_END) { fprintf(stderr, "kernel_launch: unexpected n_in %d / ws %zu\n", n_in, ws_size); grid = -1; return; }
        int dev = 0, cus = 0, per_cu = 0;
        if (hipGetDevice(&dev) != hipSuccess || hipDeviceGetAttribute(&cus, hipDeviceAttributeMultiprocessorCount, dev) != hipSuccess) { grid = -1; return; }
        if (hipFuncSetAttribute((const void*)mega_fwd, hipFuncAttributeMaxDynamicSharedMemorySize, LDS_BYTES) != hipSuccess) { fprintf(stderr, "kernel_launch: hipFuncSetAttribute failed\n"); grid = -1; return; }
        if (hipOccupancyMaxActiveBlocksPerMultiprocessor(&per_cu, (const void*)mega_fwd, 512, LDS_BYTES) != hipSuccess || per_cu < 1) { fprintf(stderr, "kernel_launch: occupancy query says %d blocks per CU\n", per_cu); (void)hipGetLastError(); grid = -1; return; }
        grid = cus;
    }
    if (grid < 0) return;
    (void)hipMemsetAsync((char*)d_ws + WS_CTL, 0, CTL_ZERO_BYTES, stream);
    Args a; memset(&a, 0, sizeof(a));
    for (int i = 0; i < 25; ++i) a.in[i] = (const float*)d_in[i];
    a.out = (float*)d_out; a.ws = (unsigned char*)d_ws;
#ifdef DBG_PTR
    {
        const char* w0 = (const char*)d_ws; const char* w1 = w0 + ws_size; const char* o0 = (const char*)d_out; const char* o1 = o0 + (size_t)out_size * 4;
        float code = (float)((double)(ws_size >> 20) / 10000.0);
        if (o0 < w1 && w0 < o1) code += 1.0f;
        for (int i = 0; i < n_in; ++i) { const char* p0 = (const char*)d_in[i]; const char* p1 = p0 + (size_t)in_sizes[i] * 4; if (p0 < w1 && w0 < p1) code += 2.0f; if (p0 < o1 && o0 < p1) code += 4.0f; }
        nv::forward(d_in, (float*)d_out, (unsigned char*)d_ws, stream);
        hipLaunchKernelGGL(dbg_scale_imm, dim3(1024), dim3(256), 0, stream, (float*)d_out + (size_t)MP * D, (size_t)1048576, 1.0f + code);
        return; }
#endif
#ifdef DBG_SUB
    {
        float* o = (float*)d_out; unsigned char* w = (unsigned char*)d_ws; float* save = (float*)((char*)d_ws + 508 * MiB);
#if defined(DBG_DIFF) && DBG_DIFF >= 6
        (void)hipMemsetAsync((char*)d_ws + 600 * MiB, 0, 256, stream);
#endif
        for (int p = 0; p <= 5; ++p) { a.ph_lo = p; a.ph_hi = p + 1; hipLaunchKernelGGL(mega_fwd, dim3(grid), dim3(512), LDS_BYTES, stream, a); }
#if defined(DBG_DIFF) && DBG_DIFF >= 6
        {   const bf16_t* base = (const bf16_t*)(w + (DBG_DIFF == 6 ? WS_SGA : DBG_DIFF == 7 ? WS_SGB : DBG_DIFF == 8 ? WS_SGA : WS_RV)); const size_t o2 = DBG_DIFF == 8 ? 0 : (DBG_DIFF == 9 ? 0 : (size_t)MP * D); const size_t nn = DBG_DIFF == 8 ? (size_t)MP * D : (DBG_DIFF == 9 ? (size_t)MT * 2048 : (size_t)MS * D);
            hipLaunchKernelGGL(dbg_fracbad, dim3(1024), dim3(256), 0, stream, base + o2, nn, (unsigned*)((char*)d_ws + 600 * MiB) + 1);
            hipLaunchKernelGGL(dbg_frac2code, dim3(1), dim3(1), 0, stream, (unsigned*)((char*)d_ws + 600 * MiB), nn); }
#endif
        float* sc = (float*)(w + 8 * MiB); size_t off = 0; auto carve = [&](size_t n) { float* p = sc + off; off += n; return p; };
        const int R = MS, L = 8, seq0 = 8;
        float* MODn = carve((size_t)NSEQ * NMOD); float* SC = carve((size_t)NSEQ * D); float* X = carve((size_t)R * D); float* H = carve((size_t)R * D); float* G = carve((size_t)R * DFF); float* U = carve((size_t)R * D); float* V = carve((size_t)R * D);
        float* Q = carve((size_t)R * D); float* K = carve((size_t)R * D); float* RV = carve((size_t)R * 2048); float* OR = carve((size_t)R * 2048); float* GA = carve((size_t)R * D); float* GB = carve((size_t)R * D); float* MG = carve((size_t)R * D); float* Y = carve((size_t)R * D);
        const float* x_sample = (const float*)d_in[1]; const float* state_ret = (const float*)d_in[2]; const float* c_prompt = (const float*)d_in[3]; const float* c_sample = (const float*)d_in[4]; const float* w_ada = (const float*)d_in[5]; const float* b_ada = (const float*)d_in[6];
        const float* n1_g = (const float*)d_in[7]; const float* w1_gate = (const float*)d_in[8]; const float* w1_up = (const float*)d_in[9]; const float* w1_down = (const float*)d_in[10]; const float* nm_g = (const float*)d_in[11]; const float* w_in = (const float*)d_in[12];
        const float* gm_ln_g = (const float*)d_in[13]; const float* gm_ln_b = (const float*)d_in[14]; const float* gm_ws = (const float*)d_in[15]; const float* gm_bs = (const float*)d_in[16]; const float* w_a = (const float*)d_in[17]; const float* w_b = (const float*)d_in[18]; const float* w_o = (const float*)d_in[19];
        const float* n2_g = (const float*)d_in[20]; const float* w2_gate = (const float*)d_in[21]; const float* w2_up = (const float*)d_in[22]; const float* w2_down = (const float*)d_in[23]; const float* final_g = (const float*)d_in[24];
        const bf16_t* UOs = (const bf16_t*)(w + WS_UO) + (size_t)MP * UOLD;
        hipLaunchKernelGGL(nv::silu_rows, dim3((NSEQ * D + 255) / 256), dim3(256), 0, stream, c_prompt, c_sample, SC);
        nv::gemm<1>(stream, SC, D, w_ada, NMOD, MODn, NMOD, NSEQ, NMOD, D, b_ada);
        if (DBG_SUB & 1) hipLaunchKernelGGL(dbg_copy, dim3(1024), dim3(256), 0, stream, (const float*)(w + WS_MOD), MODn, (size_t)NSEQ * NMOD);
        hipLaunchKernelGGL(nv::norm_mod, dim3(R), dim3(256), 0, stream, x_sample, n1_g, (const float*)MODn, 0 * D, 1 * D, L, seq0, H);
        nv::gemm<0>(stream, H, D, w1_gate, DFF, G, DFF, R, DFF, D);
        nv::gemm<4>(stream, H, D, w1_up, DFF, G, DFF, R, DFF, D);
        nv::gemm<8>(stream, G, DFF, w1_down, D, X, D, R, D, DFF, x_sample, MODn + 2 * D, L, seq0, 0.5f);
        if (DBG_SUB & 64) hipLaunchKernelGGL(dbg_copy, dim3(1024), dim3(256), 0, stream, (const float*)(o + (size_t)MP * D), X, (size_t)R * D);
        hipLaunchKernelGGL(nv::norm_mod, dim3(R), dim3(256), 0, stream, (const float*)X, nm_g, (const float*)MODn, 3 * D, 4 * D, L, seq0, H);
        nv::gemm<2>(stream, H, D, w_in + 0, 10240, U, D, R, D, D);
        if (DBG_SUB & 2) hipLaunchKernelGGL(dbg_cvt, dim3(1024), dim3(256), 0, stream, UOs, UOLD, 0, U, R, D);
        nv::gemm<2>(stream, H, D, w_in + 1024, 10240, V, D, R, D, D);
        nv::gemm<0>(stream, H, D, w_in + 2048, 10240, Q, D, R, D, D);
        nv::gemm<0>(stream, H, D, w_in + 3072, 10240, K, D, R, D, D);
        nv::gemm<0>(stream, H, D, w_in + 4096, 10240, RV, 2048, R, 2048, D);
        if (DBG_SUB & 8) hipLaunchKernelGGL(dbg_cvt, dim3(1024), dim3(256), 0, stream, (const bf16_t*)(w + WS_RV) + (size_t)MP * 2048, 2048, 0, RV, R, 2048);
        nv::gemm<3>(stream, H, D, w_in + 8192, 10240, GA, D, R, D, D);
        nv::gemm<3>(stream, H, D, w_in + 9216, 10240, GB, D, R, D, D);
#if defined(DBG_DIFF) && DBG_DIFF < 6
        (void)hipMemsetAsync((char*)d_ws + 600 * MiB, 0, 256, stream);
        if (DBG_DIFF <= 2) hipLaunchKernelGGL(dbg_maxdiff, dim3(1024), dim3(256), 0, stream, (const float*)(DBG_DIFF == 1 ? GA : GB), (const bf16_t*)(w + (DBG_DIFF == 1 ? WS_SGA : WS_SGB)) + (size_t)MP * D, (size_t)R * D, (unsigned*)((char*)d_ws + 600 * MiB));
        else { const size_t nn = DBG_DIFF != 4 ? (size_t)R * D : (size_t)MP * D; hipLaunchKernelGGL(dbg_fracbad, dim3(1024), dim3(256), 0, stream, (const bf16_t*)(w + WS_SGA) + (DBG_DIFF != 4 ? (size_t)MP * D : (size_t)0), nn, (unsigned*)((char*)d_ws + 600 * MiB) + 1);
            hipLaunchKernelGGL(dbg_frac2code, dim3(1), dim3(1), 0, stream, (unsigned*)((char*)d_ws + 600 * MiB), nn); }
#endif
        if (DBG_SUB & 32) { hipLaunchKernelGGL(dbg_cvt, dim3(1024), dim3(256), 0, stream, (const bf16_t*)(w + WS_SGA) + (size_t)MP * D, D, 0, GA, R, D); hipLaunchKernelGGL(dbg_cvt, dim3(1024), dim3(256), 0, stream, (const bf16_t*)(w + WS_SGB) + (size_t)MP * D, D, 0, GB, R, D); }
        hipLaunchKernelGGL(nv::ln_rows, dim3(R), dim3(256), 0, stream, V, gm_ln_g, gm_ln_b, (float*)nullptr);
        hipLaunchKernelGGL(nv::spatial_mix, dim3((unsigned)(((size_t)R * D + 255) / 256)), dim3(256), 0, stream, U, (const float*)V, gm_ws, gm_bs, R, 8);
        hipLaunchKernelGGL(nv::rotary_qk, dim3((R * 512 + 255) / 256), dim3(256), 0, stream, Q, K, R, L, 16384);
        if (DBG_SUB & 4) { hipLaunchKernelGGL(dbg_cvt_perm, dim3(1024), dim3(256), 0, stream, (const bf16_t*)(w + WS_Q) + (size_t)MP * D, Q, R); hipLaunchKernelGGL(dbg_cvt_perm, dim3(1024), dim3(256), 0, stream, (const bf16_t*)(w + WS_K) + (size_t)MP * D, K, R); }
        hipLaunchKernelGGL(nv::retention_rec, dim3(128 * 8), dim3(256), 0, stream, (const float*)Q, (const float*)K, (const float*)RV, OR, state_ret, o + (size_t)MT * D + 64 * 128 * 256, 8);
        hipLaunchKernelGGL(nv::head_rms, dim3((R * 8 + 3) / 4), dim3(256), 0, stream, OR, R);
        if (DBG_SUB & 16) hipLaunchKernelGGL(dbg_mul_cvt, dim3(1024), dim3(256), 0, stream, UOs, UOLD, 1024, OR, R, 2048);
        else nv::gemm<5>(stream, H, D, w_in + 6144, 10240, OR, 2048, R, 2048, D);
        nv::gemm<6>(stream, U, D, w_a, D, GA, D, R, D, D);
        nv::gemm<7>(stream, OR, 2048, w_b, D, GB, D, R, D, 2048, GA);
        nv::gemm<8>(stream, GB, D, w_o, D, MG, D, R, D, D, X, MODn + 5 * D, L, seq0, 1.0f);
        hipLaunchKernelGGL(nv::norm_mod, dim3(R), dim3(256), 0, stream, (const float*)MG, n2_g, (const float*)MODn, 6 * D, 7 * D, L, seq0, H);
        nv::gemm<0>(stream, H, D, w2_gate, DFF, G, DFF, R, DFF, D);
        nv::gemm<4>(stream, H, D, w2_up, DFF, G, DFF, R, DFF, D);
        nv::gemm<8>(stream, G, DFF, w2_down, D, X, D, R, D, DFF, MG, MODn + 8 * D, L, seq0, 0.5f);
        hipLaunchKernelGGL(nv::norm_mod, dim3(R), dim3(256), 0, stream, (const float*)X, final_g, (const float*)nullptr, 0, 0, L, seq0, Y);
        hipLaunchKernelGGL(dbg_copy, dim3(1024), dim3(256), 0, stream, (const float*)Y, save, (size_t)1048576);
#ifdef DBG_DIFF
        hipLaunchKernelGGL(dbg_copy, dim3(1), dim3(64), 0, stream, (const float*)((char*)d_ws + 600 * MiB), save + 1048576 - 64 + 1048576 / 1048576 * 0 + 0, (size_t)0);
        hipLaunchKernelGGL(dbg_copy, dim3(1), dim3(64), 0, stream, (const float*)((char*)d_ws + 600 * MiB), (float*)((char*)d_ws + 601 * MiB), (size_t)16);
#endif
        nv::forward(d_in, o, (unsigned char*)d_ws, stream);
        hipLaunchKernelGGL(dbg_copy, dim3(1024), dim3(256), 0, stream, (const float*)save, o + (size_t)MP * D, (size_t)1048576);
#ifdef DBG_DIFF
        hipLaunchKernelGGL(dbg_scale, dim3(1024), dim3(256), 0, stream, o + (size_t)MP * D, (size_t)1048576, (const unsigned*)((char*)d_ws + 601 * MiB));
#endif
        return; }
#endif
#ifdef DBG_HYB
    {
        float* o = (float*)d_out; unsigned char* w = (unsigned char*)d_ws; float* save = (float*)((char*)d_ws + 508 * MiB);
        const int klast = DBG_HYB == 1 ? 7 : (DBG_HYB == 2 ? 9 : 5);
        for (int p = 0; p <= klast; ++p) { a.ph_lo = p; a.ph_hi = p + 1; hipLaunchKernelGGL(mega_fwd, dim3(grid), dim3(512), LDS_BYTES, stream, a); }
        float* sc = (float*)(w + 8 * MiB);
        size_t off = 0; auto carve = [&](size_t n) { float* p = sc + off; off += n; return p; };
        const int R = MS;
        float* Xs = carve((size_t)R * D); float* Hh = carve((size_t)R * D); float* G = carve((size_t)R * DFF); float* U = carve((size_t)R * D); float* ORb = carve((size_t)R * 2048);
        float* GA = carve((size_t)R * D); float* GB = carve((size_t)R * D); float* MG = carve((size_t)R * D); float* Y = carve((size_t)R * D);
        const float* MODm = (const float*)(w + WS_MOD); const float* Xm = o + (size_t)MP * D;
        const float* w_a = (const float*)d_in[17]; const float* w_b = (const float*)d_in[18]; const float* w_o = (const float*)d_in[19]; const float* n2_g = (const float*)d_in[20];
        const float* w2_gate = (const float*)d_in[21]; const float* w2_up = (const float*)d_in[22]; const float* w2_down = (const float*)d_in[23]; const float* final_g = (const float*)d_in[24];
        const bf16_t* UOs = (const bf16_t*)(w + WS_UO) + (size_t)MP * UOLD;
        if (DBG_HYB == 1) {
            hipLaunchKernelGGL(dbg_cvt, dim3(1024), dim3(256), 0, stream, UOs, UOLD, 0, U, R, D);
            hipLaunchKernelGGL(dbg_cvt, dim3(1024), dim3(256), 0, stream, UOs, UOLD, 1024, ORb, R, 2048);
            hipLaunchKernelGGL(dbg_cvt, dim3(1024), dim3(256), 0, stream, (const bf16_t*)(w + WS_SGA) + (size_t)MP * D, D, 0, GA, R, D);
            hipLaunchKernelGGL(dbg_cvt, dim3(1024), dim3(256), 0, stream, (const bf16_t*)(w + WS_SGB) + (size_t)MP * D, D, 0, GB, R, D);
            nv::gemm<6>(stream, U, D, w_a, D, GA, D, R, D, D);
            nv::gemm<7>(stream, ORb, 2048, w_b, D, GB, D, R, D, 2048, GA);
            nv::gemm<8>(stream, GB, D, w_o, D, MG, D, R, D, D, Xm, MODm + 5 * D, 8, 8, 1.0f);
        } else if (DBG_HYB == 3) {
            float* V = carve((size_t)R * D); float* Q = carve((size_t)R * D); float* K = carve((size_t)R * D); float* RV = carve((size_t)R * 2048);
            const float* gm_ln_g = (const float*)d_in[13]; const float* gm_ln_b = (const float*)d_in[14]; const float* gm_ws = (const float*)d_in[15]; const float* gm_bs = (const float*)d_in[16]; const float* state_ret = (const float*)d_in[2];
            hipLaunchKernelGGL(dbg_cvt, dim3(1024), dim3(256), 0, stream, UOs, UOLD, 0, U, R, D);
            hipLaunchKernelGGL(dbg_cvt, dim3(1024), dim3(256), 0, stream, (const bf16_t*)(w + WS_V) + (size_t)MP * D, D, 0, V, R, D);
            hipLaunchKernelGGL(dbg_cvt_perm, dim3(1024), dim3(256), 0, stream, (const bf16_t*)(w + WS_Q) + (size_t)MP * D, Q, R);
            hipLaunchKernelGGL(dbg_cvt_perm, dim3(1024), dim3(256), 0, stream, (const bf16_t*)(w + WS_K) + (size_t)MP * D, K, R);
            hipLaunchKernelGGL(dbg_cvt, dim3(1024), dim3(256), 0, stream, (const bf16_t*)(w + WS_RV) + (size_t)MP * 2048, 2048, 0, RV, R, 2048);
            hipLaunchKernelGGL(dbg_cvt, dim3(1024), dim3(256), 0, stream, (const bf16_t*)(w + WS_SGA) + (size_t)MP * D, D, 0, GA, R, D);
            hipLaunchKernelGGL(dbg_cvt, dim3(1024), dim3(256), 0, stream, (const bf16_t*)(w + WS_SGB) + (size_t)MP * D, D, 0, GB, R, D);
            hipLaunchKernelGGL(nv::ln_rows, dim3(R), dim3(256), 0, stream, V, gm_ln_g, gm_ln_b, (float*)nullptr);
            hipLaunchKernelGGL(nv::spatial_mix, dim3((unsigned)(((size_t)R * D + 255) / 256)), dim3(256), 0, stream, U, (const float*)V, gm_ws, gm_bs, R, 8);
            hipLaunchKernelGGL(nv::retention_rec, dim3(128 * 8), dim3(256), 0, stream, (const float*)Q, (const float*)K, (const float*)RV, ORb, state_ret, o + (size_t)MT * D + 64 * 128 * 256, 8);
            hipLaunchKernelGGL(nv::head_rms, dim3((R * 8 + 3) / 4), dim3(256), 0, stream, ORb, R);
            hipLaunchKernelGGL(dbg_mul_cvt, dim3(1024), dim3(256), 0, stream, UOs, UOLD, 1024, ORb, R, 2048);
            nv::gemm<6>(stream, U, D, w_a, D, GA, D, R, D, D);
            nv::gemm<7>(stream, ORb, 2048, w_b, D, GB, D, R, D, 2048, GA);
            nv::gemm<8>(stream, GB, D, w_o, D, MG, D, R, D, D, Xm, MODm + 5 * D, 8, 8, 1.0f);
        } else {
            hipLaunchKernelGGL(dbg_copy, dim3(1024), dim3(256), 0, stream, Xm, MG, (size_t)R * D);
        }
        hipLaunchKernelGGL(nv::norm_mod, dim3(R), dim3(256), 0, stream, (const float*)MG, n2_g, MODm, 6 * D, 7 * D, 8, 8, Hh);
        nv::gemm<0>(stream, Hh, D, w2_gate, DFF, G, DFF, R, DFF, D);
        nv::gemm<4>(stream, Hh, D, w2_up, DFF, G, DFF, R, DFF, D);
        nv::gemm<8>(stream, G, DFF, w2_down, D, Xs, D, R, D, DFF, MG, MODm + 8 * D, 8, 8, 0.5f);
        hipLaunchKernelGGL(nv::norm_mod, dim3(R), dim3(256), 0, stream, (const float*)Xs, final_g, (const float*)nullptr, 0, 0, 8, 8, Y);
        hipLaunchKernelGGL(dbg_copy, dim3(1024), dim3(256), 0, stream, (const float*)Y, save, (size_t)1048576);
        nv::forward(d_in, o, (unsigned char*)d_ws, stream);
        hipLaunchKernelGGL(dbg_copy, dim3(1024), dim3(256), 0, stream, (const float*)save, o + (size_t)MP * D, (size_t)1048576);
        return; }
#endif
#ifdef DBG_MIX
    {   float* o = (float*)d_out; float* save = (float*)((char*)d_ws + 508 * MiB);
        const size_t off = DBG_MIX == 1 ? (size_t)54525952 - 1048576 : (size_t)MP * D;
        for (int p = 0; p < NPHASE; ++p) { a.ph_lo = p; a.ph_hi = p + 1; hipLaunchKernelGGL(mega_fwd, dim3(grid), dim3(512), LDS_BYTES, stream, a); }
        hipLaunchKernelGGL(dbg_copy, dim3(1024), dim3(256), 0, stream, (const float*)(o + off), save, (size_t)1048576);
        nv::forward(d_in, o, (unsigned char*)d_ws, stream);
        hipLaunchKernelGGL(dbg_copy, dim3(1024), dim3(256), 0, stream, (const float*)save, o + off, (size_t)1048576);
        return; }
#endif
#ifdef DBG_CK
    {   unsigned long long* ck = (unsigned long long*)((char*)d_ws + 508 * MiB);
        (void)hipMemsetAsync(ck, 0, 4096, stream);
        for (int run = 0; run < DBG_CK; ++run) {
            (void)hipMemsetAsync((char*)d_ws + WS_CTL, 0, CTL_ZERO_BYTES, stream);
            for (int p = 0; p < NPHASE; ++p) { a.ph_lo = p; a.ph_hi = p + 1; hipLaunchKernelGGL(mega_fwd, dim3(grid), dim3(512), LDS_BYTES, stream, a);
                hipLaunchKernelGGL(dbg_cksum, dim3(2048), dim3(256), 0, stream, (const unsigned*)d_ws, (size_t)(508 * MiB / 4), ck + 16 * run + p);
                hipLaunchKernelGGL(dbg_cksum, dim3(2048), dim3(256), 0, stream, (const unsigned*)d_out, (size_t)out_size, ck + 16 * run + p); }
        }
        hipLaunchKernelGGL(dbg_encode, dim3(1024), dim3(256), 0, stream, ck, (float*)d_out + (size_t)MP * D, (size_t)MS * D, NPHASE);
        return; }
#endif
#ifdef DBG_LAST
    {   float* o = (float*)d_out; unsigned char* w = (unsigned char*)d_ws; const size_t NT = (size_t)MT * D;
        for (int p = 0; p <= DBG_LAST; ++p) { a.ph_lo = p; a.ph_hi = p + 1; hipLaunchKernelGGL(mega_fwd, dim3(grid), dim3(512), LDS_BYTES, stream, a); }
#if DBG_LAST == 5
        hipLaunchKernelGGL(dbg_dump_bf16, dim3(2048), dim3(256), 0, stream, (const bf16_t*)(w + WS_Q), o, NT);
        hipLaunchKernelGGL(dbg_dump_bf16, dim3(2048), dim3(256), 0, stream, (const bf16_t*)(w + WS_K), o + NT, NT);
        hipLaunchKernelGGL(dbg_dump_bf16, dim3(2048), dim3(256), 0, stream, (const bf16_t*)(w + WS_V), o + 2 * NT, NT);
        hipLaunchKernelGGL(dbg_fill, dim3(2048), dim3(256), 0, stream, o + 3 * NT, (size_t)out_size - 3 * NT);
#endif
        return; }
#endif
#if MK_PER_PHASE
    for (int p = 0; p < NPHASE; ++p) { a.ph_lo = p; a.ph_hi = p + 1; hipLaunchKernelGGL(mega_fwd, dim3(grid), dim3(512), LDS_BYTES, stream, a); }
#else
    a.ph_lo = 0; a.ph_hi = NPHASE; hipLaunchKernelGGL(mega_fwd, dim3(grid), dim3(512), LDS_BYTES, stream, a);
#endif
}
```

```cpp
#include <hip/hip_runtime.h>
#include <cstdio>
#include <cstdint>
#include <cstring>

#define LAS __attribute__((address_space(3)))
#define GAS __attribute__((address_space(1)))
typedef unsigned short bf16_t;
typedef short bf16x8 __attribute__((ext_vector_type(8)));
typedef short s16x4 __attribute__((ext_vector_type(4)));
typedef short v4i16_t __attribute__((ext_vector_type(4)));
typedef float f32x4 __attribute__((ext_vector_type(4)));
typedef float f32x2 __attribute__((ext_vector_type(2)));
typedef float f32x16 __attribute__((ext_vector_type(16)));
typedef unsigned u32x4 __attribute__((ext_vector_type(4)));
typedef unsigned u32x2 __attribute__((ext_vector_type(2)));

#ifndef MK_PER_PHASE
#define MK_PER_PHASE 0
#endif

constexpr int D = 1024, DFF = 2816, NIN = 10240, NMOD = 9216, NSEQ = 136, MP = 16384, MS = 1024, MT = 17408, NGU = 2 * DFF;
constexpr int UOLD = 3072;
constexpr float EPS = 1e-6f;
constexpr int NPHASE = 14;

constexpr size_t MiB = 1u << 20;
constexpr size_t WS_CTL = 0, CTL_ZERO_BYTES = 1 * MiB;
constexpr size_t WS_MOD = 1 * MiB, WS_ROPEC = 6 * MiB, WS_ROPES = 7 * MiB;
constexpr size_t WS_W1GU = 8 * MiB, WS_W1D = 19 * MiB, WS_W2GU = 25 * MiB, WS_W2D = 36 * MiB, WS_WIN = 42 * MiB, WS_WAB = 62 * MiB, WS_WO = 68 * MiB;
constexpr size_t WS_H = 70 * MiB;
constexpr size_t WS_UO = 104 * MiB, WS_V = 206 * MiB, WS_Q = 240 * MiB, WS_K = 274 * MiB, WS_RV = 308 * MiB, WS_SGA = 376 * MiB, WS_SGB = 410 * MiB;
constexpr size_t WS_HID = 104 * MiB;
constexpr size_t WS_ST = 444 * MiB;
constexpr size_t WS_U = 508 * MiB, WS_RG = 542 * MiB;
constexpr size_t WS_END = 610 * MiB;
constexpr int CW_TMO = 0, CW_BAR = 4096, CW_VSTAT = 16384;

constexpr int LDS_BYTES = 147456, MISC_OFF = LDS_BYTES - 512;

#define RLX_AGENT __ATOMIC_RELAXED, __HIP_MEMORY_SCOPE_AGENT
typedef __bf16 bf16x2_t __attribute__((ext_vector_type(2)));
__device__ __forceinline__ unsigned cvt_pk_bf16(float lo, float hi) { return __builtin_bit_cast(unsigned, __builtin_convertvector((f32x2){lo, hi}, bf16x2_t)); }
__device__ __forceinline__ float bf_lo(unsigned w) { return __uint_as_float(w << 16); }
__device__ __forceinline__ float bf_hi(unsigned w) { return __uint_as_float(w & 0xffff0000u); }
__device__ __forceinline__ float fsigmoid(float x) { return __builtin_amdgcn_rcpf(1.f + __builtin_amdgcn_exp2f(-1.4426950408889634f * x)); }
__device__ __forceinline__ float fsilu(float x) { return x * fsigmoid(x); }
__device__ __forceinline__ float fgelu(float x) { return x * fsigmoid(1.5957691216057308f * (x + 0.044715f * x * x * x)); }
__device__ __forceinline__ float wave_sum(float v) {
#pragma unroll
    for (int o = 1; o < 64; o <<= 1) v += __shfl_xor(v, o);
    return v;
}
__device__ __forceinline__ int seq_of(int row) { return row < MP ? (row >> 11) : 8 + ((row - MP) >> 3); }
__device__ __forceinline__ int posidx_of(int row) { return row < MP ? (row & 2047) : 2048 + ((row - MP) & 7); }
__device__ __forceinline__ int dorig_of(int p) { return 16 * (p >> 5) + 4 * ((p >> 3) & 3) + (p & 3) + 64 * ((p >> 2) & 1); }
__device__ __forceinline__ s16x4 tr_read(const LAS unsigned char* p) { return __builtin_bit_cast(s16x4, __builtin_amdgcn_ds_read_tr16_b64_v4i16((LAS v4i16_t*)p)); }
__device__ __forceinline__ bf16x8 cat4(s16x4 a, s16x4 b) { return (bf16x8){a[0], a[1], a[2], a[3], b[0], b[1], b[2], b[3]}; }
__device__ __forceinline__ bf16x8 as_bf16x8(u32x4 v) { return __builtin_bit_cast(bf16x8, v); }

namespace pg8 {
constexpr int BM = 256, BK = 64, HALF = 128, HTB = HALF * BK * 2, STAGE_BYTES = 8 * HTB, NXCD = 8, WGM = 8;
__host__ __device__ __forceinline__ int lds_byte(int r, int c) { const int st = (r >> 4) * 2 + (c >> 5), rr = r & 15, cc = c & 31, ob = rr * 64 + cc * 2; return st * 1024 + (ob ^ (((ob >> 9) & 1) << 5)); }
__host__ __device__ __forceinline__ void stage_rc(int b, int& R, int& C) { const int st = b / 1024, sb = b % 1024, swz = sb ^ (((sb >> 9) & 1) << 5); R = (st >> 1) * 16 + swz / 64; C = (st & 1) * 32 + (swz % 64) / 2; }
__host__ __device__ __forceinline__ int perm32(int rho) { const int n = rho >> 4, i = rho & 15; return 8 * (i >> 2) + 4 * n + (i & 3); }
struct Unit { int pm, pn; };
struct Gemm { const bf16_t* A; const bf16_t* Bt; int M, N, K; };
struct StaticOrder {
    int nM, nN, nwg, G, c;
    __device__ void init(int M, int N, int G_, int c_) { nM = M / BM; nN = N / BM; nwg = nM * nN; G = G_; c = c_; }
    __device__ bool next(int i, Unit& u) const {
#ifdef DBG_REV
        long L = (long)i * G + c; if (L >= nwg) return false; { const int cnt = (nwg - c + G - 1) / G; L = (long)(cnt - 1 - i) * G + c; }
#else
        const long L = (long)i * G + c; if (L >= nwg) return false;
#endif
        int wgid = (int)L; { const int q = nwg / NXCD, r = nwg % NXCD, xcd = wgid % NXCD, off = wgid / NXCD; wgid = (xcd < r ? xcd * (q + 1) : r * (q + 1) + (xcd - r) * q) + off; }
        const int nig = WGM * nN, gid = wgid / nig, fm = gid * WGM, gsz = (nM - fm) < WGM ? (nM - fm) : WGM;
        u.pm = fm + ((wgid % nig) % gsz); u.pn = (wgid % nig) / gsz; return true;
    }
};
template <class Epi, class Sched>
__device__ __forceinline__ void gemm_phase(LAS unsigned char* lds, const Gemm g, const Sched& S, const Epi& E) {
    const int tid = threadIdx.x, wid = __builtin_amdgcn_readfirstlane(tid >> 6), lane = tid & 63, wr = wid >> 2, wc = wid & 3, fr = lane & 15, fq = lane >> 4;
    const int K = g.K, nt = K / BK;
    unsigned voffA[2], voffB[2];
#pragma unroll
    for (int i = 0; i < 2; ++i) { int R, C; stage_rc(tid * 16 + i * 8192, R, C); const int Rb = Epi::PERM ? ((R & ~31) + perm32(R & 31)) : R;
        voffA[i] = (unsigned)(R * K + C) * 2u; voffB[i] = (unsigned)(Rb * K + C) * 2u; }
    const size_t kstep = (size_t)(BK * 2);
    const size_t hstep = (size_t)HALF * K * 2;
    const size_t tstep = 2 * hstep;
    const unsigned ldsw = (unsigned)wid * 1024u;
    const int aoff = lds_byte(wr * 64 + fr, fq * 8), boff = lds_byte(wc * 32 + fr, fq * 8);
#define PG8_SA(b, h) (((b) * 2 + (h)) * HTB)
#define PG8_SB(b, h) ((4 + (b) * 2 + (h)) * HTB)
#define PG8_STAGE(bufoff, gbase, voff) do { _Pragma("unroll") for (int _i = 0; _i < 2; ++_i) \
        __builtin_amdgcn_global_load_lds((const unsigned*)((const char*)(gbase) + (voff)[_i]), (LAS unsigned*)(lds + (bufoff) + ldsw + _i * 8192), 16, 0, 0); } while (0)
#define PG8_LDA(dst, b, h) do { _Pragma("unroll") for (int m = 0; m < 4; ++m) _Pragma("unroll") for (int k = 0; k < 2; ++k) dst[m][k] = *(const LAS bf16x8*)(lds + PG8_SA(b, h) + aoff + m * 2048 + k * 1024); } while (0)
#define PG8_LDB(dst, b, h) do { _Pragma("unroll") for (int n = 0; n < 2; ++n) _Pragma("unroll") for (int k = 0; k < 2; ++k) dst[n][k] = *(const LAS bf16x8*)(lds + PG8_SB(b, h) + boff + n * 2048 + k * 1024); } while (0)
#define PG8_MMA(ai, bj, At, Bt) do { __builtin_amdgcn_s_setprio(1); _Pragma("unroll") for (int m = 0; m < 4; ++m) _Pragma("unroll") for (int n = 0; n < 2; ++n) _Pragma("unroll") for (int k = 0; k < 2; ++k) \
        acc[ai][bj][m][n] = __builtin_amdgcn_mfma_f32_16x16x32_bf16(Bt[n][k], At[m][k], acc[ai][bj][m][n], 0, 0, 0); __builtin_amdgcn_s_setprio(0); } while (0)
#define PG8_WAIT_V(n) asm volatile("s_waitcnt vmcnt(" #n ")" ::: "memory")
#define PG8_WAIT_L(n) asm volatile("s_waitcnt lgkmcnt(" #n ")" ::: "memory")
#define PG8_BAR __builtin_amdgcn_s_barrier()
#define PG8_SCHED __builtin_amdgcn_sched_barrier(0)
    Unit cur, nxt; int ui = 0;
    if (!S.next(0, cur)) return;
    f32x4 acc[2][2][4][2];
#pragma unroll
    for (int a = 0; a < 2; ++a)
#pragma unroll
        for (int b = 0; b < 2; ++b)
#pragma unroll
            for (int m = 0; m < 4; ++m)
#pragma unroll
                for (int n = 0; n < 2; ++n) acc[a][b][m][n] = (f32x4){0.f, 0.f, 0.f, 0.f};
    bf16x8 At[4][2], B0[2][2], B1[2][2];
    const char* cA = (const char*)g.A + (size_t)cur.pm * tstep; const char* cB = (const char*)g.Bt + (size_t)cur.pn * tstep;
    PG8_STAGE(PG8_SB(0, 0), cB, voffB); PG8_STAGE(PG8_SB(0, 1), cB + hstep, voffB); PG8_STAGE(PG8_SA(0, 0), cA, voffA); PG8_STAGE(PG8_SA(0, 1), cA + hstep, voffA);
    if (wr == 1) PG8_BAR;
    PG8_WAIT_V(2); PG8_BAR;
    PG8_STAGE(PG8_SB(1, 0), cB + kstep, voffB); PG8_STAGE(PG8_SA(1, 0), cA + kstep, voffA); PG8_STAGE(PG8_SB(1, 1), cB + hstep + kstep, voffB);
    PG8_WAIT_V(6); PG8_BAR;
    for (;;) {
        const bool has_next = S.next(ui + 1, nxt);
        const char* nA = has_next ? (const char*)g.A + (size_t)nxt.pm * tstep : cA; const char* nB = has_next ? (const char*)g.Bt + (size_t)nxt.pn * tstep : cB;
        for (int t = 0; t < nt; t += 2) {
            if constexpr (Epi::MID_T > 0) { if (t == Epi::MID_T) E.mid(acc, cur, wr, wc, fr, fq); }
            const bool last = (t == nt - 2);
            const char* a1 = cA + (size_t)(t + 1) * kstep;
            const char* a2 = last ? nA : cA + (size_t)(t + 2) * kstep; const char* b2 = last ? nB : cB + (size_t)(t + 2) * kstep;
            const char* a3 = a2 + kstep; const char* b3 = b2 + kstep;
            PG8_LDB(B0, 0, 0); PG8_LDB(B1, 0, 1); PG8_SCHED; PG8_LDA(At, 0, 0); PG8_STAGE(PG8_SA(1, 1), a1 + hstep, voffA);
            PG8_WAIT_V(8); PG8_WAIT_L(0); PG8_BAR; PG8_MMA(0, 0, At, B0); PG8_MMA(0, 1, At, B1); PG8_BAR; PG8_SCHED;
            PG8_LDA(At, 0, 1); PG8_STAGE(PG8_SB(0, 0), b2, voffB); PG8_STAGE(PG8_SB(0, 1), b2 + hstep, voffB); PG8_STAGE(PG8_SA(0, 0), a2, voffA);
            PG8_WAIT_V(8); PG8_WAIT_L(0); PG8_BAR; PG8_MMA(1, 0, At, B0); PG8_MMA(1, 1, At, B1); PG8_BAR; PG8_SCHED;
            PG8_LDB(B0, 1, 0); PG8_LDB(B1, 1, 1); PG8_SCHED; PG8_LDA(At, 1, 0); PG8_STAGE(PG8_SA(0, 1), a2 + hstep, voffA);
            PG8_WAIT_V(8); PG8_WAIT_L(0); PG8_BAR; PG8_MMA(0, 0, At, B0); PG8_MMA(0, 1, At, B1); PG8_BAR; PG8_SCHED;
            PG8_LDA(At, 1, 1); PG8_STAGE(PG8_SB(1, 0), b3, voffB); PG8_STAGE(PG8_SB(1, 1), b3 + hstep, voffB); PG8_STAGE(PG8_SA(1, 0), a3, voffA);
            PG8_WAIT_V(8); PG8_WAIT_L(0); PG8_BAR; PG8_MMA(1, 0, At, B0); PG8_MMA(1, 1, At, B1); PG8_BAR; PG8_SCHED;
        }
        if (wr == 0) PG8_BAR;
        E(acc, cur, wr, wc, fr, fq);
        if (!has_next) break;
#pragma unroll
        for (int a = 0; a < 2; ++a)
#pragma unroll
            for (int b = 0; b < 2; ++b)
#pragma unroll
                for (int m = 0; m < 4; ++m)
#pragma unroll
                    for (int n = 0; n < 2; ++n) acc[a][b][m][n] = (f32x4){0.f, 0.f, 0.f, 0.f};
        cur = nxt; cA = nA; cB = nB; ++ui;
        if (wr == 1) PG8_BAR;
    }
    PG8_WAIT_V(0);
    PG8_BAR;
#ifdef DBG_REDO
    E(acc, cur, wr, wc, fr, fq);
#endif
#undef PG8_SA
#undef PG8_SB
#undef PG8_STAGE
#undef PG8_LDA
#undef PG8_LDB
#undef PG8_MMA
#undef PG8_WAIT_V
#undef PG8_WAIT_L
#undef PG8_BAR
#undef PG8_SCHED
}
}
using pg8::Unit;
typedef const f32x4 (&AccC)[2][2][4][2];
typedef f32x4 (&AccM)[2][2][4][2];

struct EpiGateUp {
    static constexpr bool PERM = true; static constexpr int MID_T = 0;
    bf16_t* HID;
    __device__ __forceinline__ void operator()(AccC acc, const Unit& u, int wr, int wc, int fr, int fq) const {
        const int row0 = u.pm * 256 + wr * 64 + fr, col0 = u.pn * 128 + wc * 32 + 8 * fq;
#pragma unroll
        for (int ai = 0; ai < 2; ++ai)
#pragma unroll
            for (int m = 0; m < 4; ++m) {
                const f32x4 g0 = acc[ai][0][m][0], g1 = acc[ai][0][m][1], u0 = acc[ai][1][m][0], u1 = acc[ai][1][m][1];
                u32x4 w;
                w.x = cvt_pk_bf16(fsilu(g0[0]) * u0[0], fsilu(g0[1]) * u0[1]); w.y = cvt_pk_bf16(fsilu(g0[2]) * u0[2], fsilu(g0[3]) * u0[3]);
                w.z = cvt_pk_bf16(fsilu(g1[0]) * u1[0], fsilu(g1[1]) * u1[1]); w.w = cvt_pk_bf16(fsilu(g1[2]) * u1[2], fsilu(g1[3]) * u1[3]);
                *(u32x4*)(HID + (size_t)(row0 + ai * 128 + m * 16) * DFF + col0) = w;
            }
    }
};
struct EpiResid {
    static constexpr bool PERM = false; static constexpr int MID_T = 0;
    const float* xin_p; const float* xin_s; float* X; const float* mod; int goff; float scale;
    __device__ __forceinline__ void operator()(AccC acc, const Unit& u, int wr, int wc, int fr, int fq) const {
        const int row0 = u.pm * 256 + wr * 64 + fr, col0 = u.pn * 256 + wc * 32 + 4 * fq;
        const float* xin = (u.pm < MP / 256) ? xin_p : xin_s - (size_t)MP * D;
#pragma unroll
        for (int ai = 0; ai < 2; ++ai)
#pragma unroll
            for (int m = 0; m < 4; ++m) {
                const int row = row0 + ai * 128 + m * 16; const float* gp = mod + (size_t)seq_of(row) * NMOD + goff + col0; const size_t off = (size_t)row * D + col0;
#pragma unroll
                for (int bj = 0; bj < 2; ++bj)
#pragma unroll
                    for (int n = 0; n < 2; ++n) { const f32x4 xv = *(const f32x4*)(xin + off + bj * 128 + n * 16), gv = *(const f32x4*)(gp + bj * 128 + n * 16);
                        *(f32x4*)(X + off + bj * 128 + n * 16) = xv + scale * gv * acc[ai][bj][m][n]; }
                if (m & 1) asm volatile("" ::: "memory");
            }
    }
};
struct EpiWin {
    static constexpr bool PERM = true; static constexpr int MID_T = 0;
    bf16_t *U, *RG, *V, *Q, *K, *RV, *SGA, *SGB; unsigned long long* vstat; const float* ropec; const float* ropes;
    template <int ACT> __device__ __forceinline__ void plain(AccC acc, bf16_t* dst, int ld, int cbase, int row0, int cw) const {
#pragma unroll
        for (int ai = 0; ai < 2; ++ai)
#pragma unroll
            for (int m = 0; m < 4; ++m) { bf16_t* rowp = dst + (size_t)(row0 + ai * 128 + m * 16) * ld + cbase + cw;
#pragma unroll
                for (int bj = 0; bj < 2; ++bj) { f32x4 v0 = acc[ai][bj][m][0], v1 = acc[ai][bj][m][1];
#pragma unroll
                    for (int i = 0; i < 4; ++i) { if (ACT == 1) { v0[i] = fgelu(v0[i]); v1[i] = fgelu(v1[i]); } else if (ACT == 2) { v0[i] = fsilu(v0[i]); v1[i] = fsilu(v1[i]); } else if (ACT == 3) { v0[i] = fsigmoid(v0[i]); v1[i] = fsigmoid(v1[i]); } }
                    u32x4 w; w.x = cvt_pk_bf16(v0[0], v0[1]); w.y = cvt_pk_bf16(v0[2], v0[3]); w.z = cvt_pk_bf16(v1[0], v1[1]); w.w = cvt_pk_bf16(v1[2], v1[3]);
                    *(u32x4*)(rowp + bj * 128) = w; }
                __builtin_amdgcn_sched_barrier(0); }
    }
    __device__ __forceinline__ void operator()(AccC acc, const Unit& u, int wr, int wc, int fr, int fq) const {
        const int pn = u.pn, row0 = u.pm * 256 + wr * 64 + fr, cw = wc * 32 + 8 * fq;
        if (pn < 4) plain<1>(acc, U, D, 256 * pn, row0, cw);
        else if (pn < 8) {
            const int cbase = 256 * (pn - 4);
#pragma unroll
            for (int ai = 0; ai < 2; ++ai)
#pragma unroll
                for (int m = 0; m < 4; ++m) { const int row = row0 + ai * 128 + m * 16; bf16_t* rowp = V + (size_t)row * D + cbase + cw; float s1 = 0.f, s2 = 0.f;
#pragma unroll
                    for (int bj = 0; bj < 2; ++bj) { f32x4 v0 = acc[ai][bj][m][0], v1 = acc[ai][bj][m][1];
#pragma unroll
                        for (int i = 0; i < 4; ++i) { v0[i] = fgelu(v0[i]); v1[i] = fgelu(v1[i]); }
                        u32x4 w; w.x = cvt_pk_bf16(v0[0], v0[1]); w.y = cvt_pk_bf16(v0[2], v0[3]); w.z = cvt_pk_bf16(v1[0], v1[1]); w.w = cvt_pk_bf16(v1[2], v1[3]);
                        *(u32x4*)(rowp + bj * 128) = w;
#pragma unroll
                        for (int i = 0; i < 4; ++i) { const float a = bf_lo(w[i]), b = bf_hi(w[i]); s1 += a + b; s2 += a * a + b * b; } }
                    s1 += __shfl_xor(s1, 16); s1 += __shfl_xor(s1, 32); s2 += __shfl_xor(s2, 16); s2 += __shfl_xor(s2, 32);
                    if (fq == 0) { atomicAdd(vstat + 2 * row, (unsigned long long)(long long)__builtin_rintf(s1 * 16777216.f)); atomicAdd(vstat + 2 * row + 1, (unsigned long long)(long long)__builtin_rintf(s2 * 16777216.f)); }
                    __builtin_amdgcn_sched_barrier(0); }
        }
        else if (pn < 16) {
            const bool isk = pn >= 12; bf16_t* dst = isk ? K : Q; const int cbase = 256 * (pn - (isk ? 12 : 8)); const float ks = isk ? 0.08838834764831845f : 1.0f; const int j0 = 16 * wc + 4 * fq;
#pragma unroll
            for (int ai = 0; ai < 2; ++ai)
#pragma unroll
                for (int m = 0; m < 4; ++m) { const int row = row0 + ai * 128 + m * 16; const int pi = posidx_of(row);
                    const f32x4 c4 = *(const f32x4*)(ropec + pi * 64 + j0) * ks, s4 = *(const f32x4*)(ropes + pi * 64 + j0) * ks; bf16_t* rowp = dst + (size_t)row * D + cbase + cw;
#pragma unroll
                    for (int bj = 0; bj < 2; ++bj) { const f32x4 x1 = acc[ai][bj][m][0], x2 = acc[ai][bj][m][1]; const f32x4 o1 = x1 * c4 - x2 * s4, o2 = x1 * s4 + x2 * c4;
                        u32x4 w; w.x = cvt_pk_bf16(o1[0], o1[1]); w.y = cvt_pk_bf16(o1[2], o1[3]); w.z = cvt_pk_bf16(o2[0], o2[1]); w.w = cvt_pk_bf16(o2[2], o2[3]);
                        *(u32x4*)(rowp + bj * 128) = w; }
                    __builtin_amdgcn_sched_barrier(0); }
        }
        else if (pn < 24) plain<0>(acc, RV, 2048, 256 * (pn - 16), row0, cw);
        else if (pn < 32) plain<2>(acc, RG, 2048, 256 * (pn - 24), row0, cw);
        else if (pn < 36) plain<3>(acc, SGA, D, 256 * (pn - 32), row0, cw);
        else plain<3>(acc, SGB, D, 256 * (pn - 36), row0, cw);
    }
};
struct EpiMerged {
    static constexpr bool PERM = true; static constexpr int MID_T = 16;
    const bf16_t *SGA, *SGB; bf16_t* OUT;
    __device__ __forceinline__ void mid(AccM acc, const Unit& u, int wr, int wc, int fr_, int fq_) const {
        int fr = fr_, fq = fq_; asm volatile("" : "+v"(fr), "+v"(fq));
        const int row0 = u.pm * 256 + wr * 64 + fr, col0 = u.pn * 256 + wc * 32 + 8 * fq;
#pragma unroll
        for (int ai = 0; ai < 2; ++ai)
#pragma unroll
            for (int m = 0; m < 4; ++m) { const size_t off = (size_t)(row0 + ai * 128 + m * 16) * D + col0;
#pragma unroll
                for (int bj = 0; bj < 2; ++bj) { const u32x4 a = *(const u32x4*)(SGA + off + bj * 128), b = *(const u32x4*)(SGB + off + bj * 128);
#pragma unroll
                    for (int i = 0; i < 2; ++i) { acc[ai][bj][m][0][2 * i] *= bf_lo(a[i]) * __builtin_amdgcn_rcpf(fmaxf(bf_lo(b[i]), 1e-30f)); acc[ai][bj][m][0][2 * i + 1] *= bf_hi(a[i]) * __builtin_amdgcn_rcpf(fmaxf(bf_hi(b[i]), 1e-30f));
                        acc[ai][bj][m][1][2 * i] *= bf_lo(a[2 + i]) * __builtin_amdgcn_rcpf(fmaxf(bf_lo(b[2 + i]), 1e-30f)); acc[ai][bj][m][1][2 * i + 1] *= bf_hi(a[2 + i]) * __builtin_amdgcn_rcpf(fmaxf(bf_hi(b[2 + i]), 1e-30f)); } }
                asm volatile("" ::: "memory"); }
    }
    __device__ __forceinline__ void operator()(AccC acc, const Unit& u, int wr, int wc, int fr, int fq) const {
        const int row0 = u.pm * 256 + wr * 64 + fr, col0 = u.pn * 256 + wc * 32 + 8 * fq;
#pragma unroll
        for (int ai = 0; ai < 2; ++ai)
#pragma unroll
            for (int m = 0; m < 4; ++m) { const size_t off = (size_t)(row0 + ai * 128 + m * 16) * D + col0;
#pragma unroll
                for (int bj = 0; bj < 2; ++bj) { const u32x4 b = *(const u32x4*)(SGB + off + bj * 128); const f32x4 v0 = acc[ai][bj][m][0], v1 = acc[ai][bj][m][1];
                    u32x4 w; w.x = cvt_pk_bf16(v0[0] * bf_lo(b[0]), v0[1] * bf_hi(b[0])); w.y = cvt_pk_bf16(v0[2] * bf_lo(b[1]), v0[3] * bf_hi(b[1]));
                    w.z = cvt_pk_bf16(v1[0] * bf_lo(b[2]), v1[1] * bf_hi(b[2])); w.w = cvt_pk_bf16(v1[2] * bf_lo(b[3]), v1[3] * bf_hi(b[3]));
                    *(u32x4*)(OUT + off + bj * 128) = w; }
                if (m & 1) asm volatile("" ::: "memory"); }
    }
};

#define XB_TMO      128
#define XB_XCNT(j)  (256  + 64 * (j))
#define XB_XSUB(j)  (1280 + 64 * (j))
#define XB_XGEN(j)  (2304 + 64 * (j))
#define XB_TOP      3328
#define XB_TOPGEN   3392
#define XCD_BAR_WORDS 3456
#define XB_SPIN_CAP (1u << 20)
__device__ __forceinline__ unsigned xb_ld(unsigned* p)              { return __hip_atomic_load(p, __ATOMIC_RELAXED, __HIP_MEMORY_SCOPE_AGENT); }
__device__ __forceinline__ unsigned xb_add(unsigned* p, unsigned v) { return __hip_atomic_fetch_add(p, v, __ATOMIC_RELAXED, __HIP_MEMORY_SCOPE_AGENT); }
__device__ __forceinline__ unsigned xb_xcc_id() { return (unsigned)__builtin_amdgcn_s_getreg((3 << 11) | 20) & 0xFu; }
#define XB_SPIN(cond, bar) do { unsigned _sp = 0; while (cond) { __builtin_amdgcn_s_sleep(1); \
    if ((++_sp & 255u) == 0u) { if (xb_ld(&(bar)[XB_TMO])) break; if (_sp > XB_SPIN_CAP) { atomicAdd(&(bar)[XB_TMO], 1u); break; } } } } while (0)
struct XcdBarrier { unsigned* bar; unsigned x; volatile LAS unsigned* st; };
__device__ __forceinline__ XcdBarrier xcd_barrier_post(unsigned* bar, volatile LAS unsigned* st) {
    XcdBarrier b; b.bar = bar; b.x = xb_xcc_id(); b.st = st;
    if (threadIdx.x == 0) (void)xb_add(&bar[XB_XCNT(b.x)], 1u);
    return b;
}
__device__ __forceinline__ void xcd_barrier_complete(unsigned* bar, unsigned x, unsigned& nloc, unsigned& nx) {
    const unsigned G = gridDim.x * gridDim.y * gridDim.z;
    unsigned sum, cnt, mine, sp = 0u;
    for (;;) {
        sum = 0u; cnt = 0u; mine = 0u;
#pragma unroll
        for (unsigned j = 0; j < 16; ++j) { const unsigned c = xb_ld(&bar[XB_XCNT(j)]); sum += c; cnt += (c > 0u) ? 1u : 0u; mine = (j == x) ? c : mine; }
        if (sum == G) break;
        __builtin_amdgcn_s_sleep(1);
        if ((++sp & 255u) == 0u) { if (xb_ld(&bar[XB_TMO])) break; if (sp > XB_SPIN_CAP) { atomicAdd(&bar[XB_TMO], 1u); break; } }
    }
    nloc = mine > 0u ? mine : 1u; nx = cnt > 0u ? cnt : 1u;
}
__device__ __forceinline__ void xcd_barrier(const XcdBarrier& b) {
    asm volatile("s_waitcnt vmcnt(0)" ::: "memory");
    __syncthreads();
    if (threadIdx.x == 0) {
        unsigned* bar = b.bar;
        __builtin_amdgcn_s_waitcnt(0);
        unsigned nloc = b.st[0], nx = b.st[1];
        if (nloc == 0u) { xcd_barrier_complete(bar, b.x, nloc, nx); b.st[0] = nloc; b.st[1] = nx; }
        const unsigned old = xb_add(&bar[XB_XSUB(b.x)], 1u);
        const unsigned gen = old / nloc;
        if (old + 1u == (gen + 1u) * nloc) {
            __builtin_amdgcn_fence(__ATOMIC_RELEASE, "agent");
            asm volatile("s_waitcnt vmcnt(0)" ::: "memory");
            const unsigned og = xb_add(&bar[XB_TOP], 1u);
            const unsigned tg = og / nx;
            if (og + 1u == (tg + 1u) * nx) xb_add(&bar[XB_TOPGEN], 1u);
            else XB_SPIN(xb_ld(&bar[XB_TOPGEN]) == tg, bar);
            __builtin_amdgcn_fence(__ATOMIC_ACQUIRE, "agent");
            xb_add(&bar[XB_XGEN(b.x)], 1u);
            asm volatile("s_waitcnt vmcnt(0)" ::: "memory");
        } else {
            XB_SPIN(xb_ld(&bar[XB_XGEN(b.x)]) == gen, bar);
            __builtin_amdgcn_fence(__ATOMIC_ACQUIRE, "agent");
            asm volatile("s_waitcnt vmcnt(0)" ::: "memory");
        }
    }
    __syncthreads();
}

struct Args { const float* in[25]; float* out; unsigned char* ws; int ph_lo, ph_hi; };
struct Frame {
    LAS unsigned char* lds; int tid, lane, wave, vcu, G;
    const float *x_prompt, *x_sample, *state_ret, *c_prompt, *c_sample, *w_ada, *b_ada, *n1_g, *w1_gate, *w1_up, *w1_down, *nm_g, *w_in, *gm_ln_g, *gm_ln_b, *gm_ws, *gm_bs, *w_a, *w_b, *w_o, *n2_g, *w2_gate, *w2_up, *w2_down, *final_g;
    float *X, *rs_prompt, *rs_sample, *gv_sample;
    float *MOD, *ROPEC, *ROPES; unsigned long long* VSTAT;
    bf16_t *W1GU, *W1D, *W2GU, *W2D, *WIN, *WAB, *WO, *H, *UO, *V, *Q, *K, *RV, *SGA, *SGB, *HID, *ST, *U, *RG;
};

template <int NK>
__device__ __forceinline__ void mini_core(Frame& F, const bf16_t* A, int lda, const bf16_t* Bt, int ldb, int row0, int col0, int kbase, f32x4& o0, f32x4& o1) {
    int tid_ = F.tid; asm volatile("" : "+v"(tid_));
    const int lane_ = tid_ & 63, fr = lane_ & 15, fq = lane_ >> 4, w8 = F.wave;
    const bf16_t* ap = A + (size_t)(row0 + fr) * lda + kbase + 32 * NK * w8 + 8 * fq; const bf16_t* bp = Bt + (size_t)(col0 + fr) * ldb + kbase + 32 * NK * w8 + 8 * fq;
    f32x4 acc[4][4];
#pragma unroll
    for (int j = 0; j < 4; ++j)
#pragma unroll
        for (int i = 0; i < 4; ++i) acc[j][i] = (f32x4){0.f, 0.f, 0.f, 0.f};
    bf16x8 fa[3][4], fb[3][4];
#define MINI_LOAD(ks) do { _Pragma("unroll") for (int i = 0; i < 4; ++i) { fa[(ks) % 3][i] = *(const bf16x8*)(ap + (size_t)(16 * i) * lda + 32 * (ks)); fb[(ks) % 3][i] = *(const bf16x8*)(bp + (size_t)(16 * i) * ldb + 32 * (ks)); } } while (0)
    MINI_LOAD(0); if (NK > 1) MINI_LOAD(1);
#pragma unroll
    for (int ks = 0; ks < NK; ++ks) {
        if (ks + 2 < NK) MINI_LOAD(ks + 2);
#pragma unroll
        for (int j = 0; j < 4; ++j)
#pragma unroll
            for (int i = 0; i < 4; ++i) acc[j][i] = __builtin_amdgcn_mfma_f32_16x16x32_bf16(fb[ks % 3][j], fa[ks % 3][i], acc[j][i], 0, 0, 0);
    }
#undef MINI_LOAD
    LAS float* part = (LAS float*)F.lds;
#pragma unroll
    for (int j = 0; j < 4; ++j)
#pragma unroll
        for (int i = 0; i < 4; ++i) *(LAS f32x4*)(part + w8 * 4096 + (16 * i + fr) * 64 + 16 * j + 4 * fq) = acc[j][i];
    __syncthreads();
    o0 = (f32x4){0.f, 0.f, 0.f, 0.f}; o1 = o0;
#pragma unroll
    for (int w = 0; w < 8; ++w) { o0 += *(const LAS f32x4*)(part + w * 4096 + tid_ * 8); o1 += *(const LAS f32x4*)(part + w * 4096 + tid_ * 8 + 4); }
    __syncthreads();
}
template <int NK>
__device__ __forceinline__ void mini_resid_tile(Frame& F, const bf16_t* A, const bf16_t* Bt, int tile, const float* Xin, float* Xout, int goff, float scale) {
    const int tm = tile >> 4, tn = tile & 15; f32x4 o0, o1;
    mini_core<NK>(F, A, 256 * NK, Bt, 256 * NK, MP + 64 * tm, 64 * tn, 0, o0, o1);
    const int row = MP + 64 * tm + (F.tid >> 3), col = 64 * tn + 8 * (F.tid & 7);
    const float* gp = F.MOD + (size_t)seq_of(row) * NMOD + goff + col; const size_t off = (size_t)row * D + col;
    const f32x4 x0 = *(const f32x4*)(Xin + off), x1 = *(const f32x4*)(Xin + off + 4), m0 = *(const f32x4*)gp, m1 = *(const f32x4*)(gp + 4);
    *(f32x4*)(Xout + off) = x0 + scale * m0 * o0; *(f32x4*)(Xout + off + 4) = x1 + scale * m1 * o1;
}
__device__ __forceinline__ void mini_merged_tile(Frame& F, int tile) {
    const int tm = tile >> 4, tn = tile & 15; f32x4 a0, a1, b0, b1;
    mini_core<4>(F, F.UO, UOLD, F.WAB, 3072, MP + 64 * tm, 64 * tn, 0, a0, a1);
    mini_core<8>(F, F.UO, UOLD, F.WAB, 3072, MP + 64 * tm, 64 * tn, 1024, b0, b1);
    const int row = MP + 64 * tm + (F.tid >> 3), col = 64 * tn + 8 * (F.tid & 7); const size_t off = (size_t)row * D + col;
    const u32x4 ga = *(const u32x4*)(F.SGA + off), gb = *(const u32x4*)(F.SGB + off);
    u32x4 w;
    w.x = cvt_pk_bf16(bf_lo(ga.x) * a0[0] + bf_lo(gb.x) * b0[0], bf_hi(ga.x) * a0[1] + bf_hi(gb.x) * b0[1]); w.y = cvt_pk_bf16(bf_lo(ga.y) * a0[2] + bf_lo(gb.y) * b0[2], bf_hi(ga.y) * a0[3] + bf_hi(gb.y) * b0[3]);
    w.z = cvt_pk_bf16(bf_lo(ga.z) * a1[0] + bf_lo(gb.z) * b1[0], bf_hi(ga.z) * a1[1] + bf_hi(gb.z) * b1[1]); w.w = cvt_pk_bf16(bf_lo(ga.w) * a1[2] + bf_lo(gb.w) * b1[2], bf_hi(ga.w) * a1[3] + bf_hi(gb.w) * b1[3]);
    *(u32x4*)(F.H + off) = w;
}

__device__ __forceinline__ int dest_row(int map, int n) {
    if (map == 0) return n;
    if (map == 1) return ((n >> 7) << 8) + (n & 127);
    if (map == 2) return ((n >> 7) << 8) + 128 + (n & 127);
    if (n < 2048 || n >= 4096) return n;
    const int d = n & 127, j = d & 63, half = d >> 6;
    return (n & ~127) + 32 * (j >> 4) + 8 * ((j >> 2) & 3) + 4 * half + (j & 3);
}
__device__ __forceinline__ void p0_transpose_item(const float* W, int N, bf16_t* WT, int Kdst, int koff, int map, LAS float* scr, int item, int lane) {
    const int nblk = N / 32, kb = item / nblk, nb = item % nblk, k0 = 64 * kb, n0 = 32 * nb;
#pragma unroll 8
    for (int i = 0; i < 32; ++i) { const int kk = 2 * i + (lane >> 5); scr[kk * 33 + (lane & 31)] = W[(size_t)(k0 + kk) * N + n0 + (lane & 31)]; }
    asm volatile("s_waitcnt lgkmcnt(0)" ::: "memory");
    const int c = lane & 7;
#pragma unroll
    for (int j = 0; j < 4; ++j) { const int n = (lane >> 3) + 8 * j; const LAS float* s = scr + (8 * c) * 33 + n;
        u32x4 o; o.x = cvt_pk_bf16(s[0 * 33], s[1 * 33]); o.y = cvt_pk_bf16(s[2 * 33], s[3 * 33]); o.z = cvt_pk_bf16(s[4 * 33], s[5 * 33]); o.w = cvt_pk_bf16(s[6 * 33], s[7 * 33]);
        *(u32x4*)(WT + (size_t)dest_row(map, n0 + n) * Kdst + koff + k0 + 8 * c) = o; }
    asm volatile("s_waitcnt lgkmcnt(0)" ::: "memory");
}
__device__ __forceinline__ void p0_prologue(Frame& F) {
    {
        LAS float* part = (LAS float*)F.lds;
        const int c = F.lane & 31, h = F.lane >> 5;
        for (int it = F.vcu; it < NMOD / 32; it += F.G) {
            const int n0 = 32 * it;
            f32x16 acc[5];
#pragma unroll
            for (int r = 0; r < 5; ++r)
#pragma unroll
                for (int i = 0; i < 16; ++i) acc[r][i] = 0.f;
            for (int ks = 0; ks < 8; ++ks) {
                const int k0 = 128 * F.wave + 16 * ks + 8 * h;
                float bv[8];
#pragma unroll
                for (int j = 0; j < 8; ++j) bv[j] = F.w_ada[(size_t)(k0 + j) * NMOD + n0 + c];
                u32x4 bw; bw.x = cvt_pk_bf16(bv[0], bv[1]); bw.y = cvt_pk_bf16(bv[2], bv[3]); bw.z = cvt_pk_bf16(bv[4], bv[5]); bw.w = cvt_pk_bf16(bv[6], bv[7]);
#pragma unroll
                for (int rt = 0; rt < 5; ++rt) {
                    const int row = 32 * rt + c; u32x4 aw = (u32x4){0u, 0u, 0u, 0u};
                    if (row < NSEQ) { const float* cp = (row < 8 ? F.c_prompt + (size_t)row * D : F.c_sample + (size_t)(row - 8) * D) + k0; const f32x4 a0 = *(const f32x4*)cp, a1 = *(const f32x4*)(cp + 4);
                        aw.x = cvt_pk_bf16(fsilu(a0[0]), fsilu(a0[1])); aw.y = cvt_pk_bf16(fsilu(a0[2]), fsilu(a0[3])); aw.z = cvt_pk_bf16(fsilu(a1[0]), fsilu(a1[1])); aw.w = cvt_pk_bf16(fsilu(a1[2]), fsilu(a1[3])); }
                    acc[rt] = __builtin_amdgcn_mfma_f32_32x32x16_bf16(as_bf16x8(aw), as_bf16x8(bw), acc[rt], 0, 0, 0);
                }
            }
#pragma unroll
            for (int rt = 0; rt < 5; ++rt)
#pragma unroll
                for (int r = 0; r < 16; ++r) { const int row = 32 * rt + (r & 3) + 8 * (r >> 2) + 4 * h; if (row < NSEQ) part[(F.wave * NSEQ + row) * 32 + c] = acc[rt][r]; }
            __syncthreads();
            for (int i = F.tid; i < NSEQ * 32; i += 512) { const int row = i >> 5, col = i & 31; float sum = F.b_ada[n0 + col];
#pragma unroll
                for (int w = 0; w < 8; ++w) sum += part[w * NSEQ * 32 + i];
                F.MOD[(size_t)row * NMOD + n0 + col] = sum; }
            __syncthreads();
        }
    }
    for (int i = F.vcu * 512 + F.tid; i < 2 * MT; i += F.G * 512) F.VSTAT[i] = 0ull;
    for (int i = F.vcu * 512 + F.tid; i < 2056 * 64; i += F.G * 512) {
        const int pi = i >> 6, j = i & 63; const int pos = pi < 2048 ? pi : 16384 + (pi - 2048);
        double inv = 1.0; for (int q = 0; q < j; ++q) inv *= 0.8659643233600653;
        const double ang = (double)pos * inv; const double kq = __builtin_rint(ang * 0.6366197723675814); const double r = ang - kq * 1.5707963267948966, r2 = r * r;
        const double sr = r * (1.0 + r2 * (-1.0 / 6 + r2 * (1.0 / 120 + r2 * (-1.0 / 5040 + r2 * (1.0 / 362880 + r2 * (-1.0 / 39916800 + r2 * (1.0 / 6227020800.0)))))));
        const double cr = 1.0 + r2 * (-0.5 + r2 * (1.0 / 24 + r2 * (-1.0 / 720 + r2 * (1.0 / 40320 + r2 * (-1.0 / 3628800 + r2 * (1.0 / 479001600.0))))));
        const int qd = ((int)kq) & 3; const double s = (qd == 0) ? sr : (qd == 1) ? cr : (qd == 2) ? -sr : -cr, c = (qd == 0) ? cr : (qd == 1) ? -sr : (qd == 2) ? -cr : sr;
        F.ROPEC[i] = (float)c; F.ROPES[i] = (float)s;
    }
    LAS float* scr = (LAS float*)(F.lds + F.wave * 16384);
    const int gw = F.vcu * 8 + F.wave, NGW = F.G * 8;
    constexpr int I_G = (D / 64) * (DFF / 32), I_D = (DFF / 64) * (D / 32), I_IN = (D / 64) * (NIN / 32), I_A = (D / 64) * (D / 32), I_B = (2048 / 64) * (D / 32);
    constexpr int NITEMS = 4 * I_G + 2 * I_D + I_IN + 2 * I_A + I_B;
    for (int it = gw; it < NITEMS; it += NGW) {
        int r = it;
        if (r < I_IN) { p0_transpose_item(F.w_in, NIN, F.WIN, D, 0, 3, scr, r, F.lane); continue; } r -= I_IN;
        if (r < I_G) { p0_transpose_item(F.w1_gate, DFF, F.W1GU, D, 0, 1, scr, r, F.lane); continue; } r -= I_G;
        if (r < I_G) { p0_transpose_item(F.w1_up, DFF, F.W1GU, D, 0, 2, scr, r, F.lane); continue; } r -= I_G;
        if (r < I_D) { p0_transpose_item(F.w1_down, D, F.W1D, DFF, 0, 0, scr, r, F.lane); continue; } r -= I_D;
        if (r < I_G) { p0_transpose_item(F.w2_gate, DFF, F.W2GU, D, 0, 1, scr, r, F.lane); continue; } r -= I_G;
        if (r < I_G) { p0_transpose_item(F.w2_up, DFF, F.W2GU, D, 0, 2, scr, r, F.lane); continue; } r -= I_G;
        if (r < I_D) { p0_transpose_item(F.w2_down, D, F.W2D, DFF, 0, 0, scr, r, F.lane); continue; } r -= I_D;
        if (r < I_A) { p0_transpose_item(F.w_a, D, F.WAB, 3072, 0, 0, scr, r, F.lane); continue; } r -= I_A;
        if (r < I_B) { p0_transpose_item(F.w_b, D, F.WAB, 3072, 1024, 0, scr, r, F.lane); continue; } r -= I_B;
        p0_transpose_item(F.w_o, D, F.WO, D, 0, 0, scr, r, F.lane);
    }
}

__device__ __forceinline__ void norm_mod_phase(Frame& F, const float* xp, const float* xs, const float* gain, int shoff, int scoff) {
    const int gw = F.vcu * 8 + F.wave, NGW = F.G * 8;
    f32x4 g4[4];
#pragma unroll
    for (int j = 0; j < 4; ++j) g4[j] = *(const f32x4*)(gain + 4 * F.lane + 256 * j);
    for (int row = gw; row < MT; row += NGW) {
        const float* xr = (row < MP ? xp + (size_t)row * D : xs + (size_t)(row - MP) * D) + 4 * F.lane;
        f32x4 v[4]; float ss = 0.f;
#pragma unroll
        for (int j = 0; j < 4; ++j) { v[j] = *(const f32x4*)(xr + 256 * j); ss += (v[j][0] * v[j][0] + v[j][1] * v[j][1]) + (v[j][2] * v[j][2] + v[j][3] * v[j][3]); }
        const float rstd = 1.0f / sqrtf(wave_sum(ss) * (1.f / D) + EPS);
        const float* mp = F.MOD + (size_t)seq_of(row) * NMOD + 4 * F.lane; bf16_t* hp = F.H + (size_t)row * D + 4 * F.lane;
#pragma unroll
        for (int j = 0; j < 4; ++j) { const f32x4 sh = *(const f32x4*)(mp + shoff + 256 * j), sc = *(const f32x4*)(mp + scoff + 256 * j); const f32x4 o = v[j] * rstd * g4[j] * (1.f + sc) + sh;
            u32x2 w; w.x = cvt_pk_bf16(o[0], o[1]); w.y = cvt_pk_bf16(o[2], o[3]); *(u32x2*)(hp + 256 * j) = w; }
    }
}
__device__ __forceinline__ void final_norm_phase(Frame& F, float dbg_scale) {
    const int gw = F.vcu * 8 + F.wave, NGW = F.G * 8;
    f32x4 g4[4];
#pragma unroll
    for (int j = 0; j < 4; ++j) g4[j] = *(const f32x4*)(F.final_g + 4 * F.lane + 256 * j);
    for (int row = gw; row < MT; row += NGW) {
        float* xr = F.X + (size_t)row * D + 4 * F.lane; f32x4 v[4]; float ss = 0.f;
#pragma unroll
        for (int j = 0; j < 4; ++j) { v[j] = *(const f32x4*)(xr + 256 * j); ss += (v[j][0] * v[j][0] + v[j][1] * v[j][1]) + (v[j][2] * v[j][2] + v[j][3] * v[j][3]); }
        const float rstd = 1.0f / sqrtf(wave_sum(ss) * (1.f / D) + EPS);
#pragma unroll
        for (int j = 0; j < 4; ++j) *(f32x4*)(xr + 256 * j) = v[j] * rstd * g4[j] * (row >= MP ? dbg_scale : 1.f);
    }
}

__device__ __forceinline__ void ln_stats(const unsigned long long* vstat, int row, float& mu, float& rstd) { const long long a = (long long)vstat[2 * row], b = (long long)vstat[2 * row + 1];
    mu = (float)a * (1.f / (16777216.f * D)); const float var = (float)b * (1.f / (16777216.f * D)) - mu * mu; rstd = 1.0f / sqrtf(fmaxf(var, 0.f) + EPS); }
__device__ __forceinline__ void ln8(const u32x4 raw, float mu, float rstd, const float* lng, const float* lnb, float (&o)[8]) {
    const f32x4 g0 = *(const f32x4*)lng, g1 = *(const f32x4*)(lng + 4), b0 = *(const f32x4*)lnb, b1 = *(const f32x4*)(lnb + 4);
    o[0] = (bf_lo(raw.x) - mu) * rstd * g0[0] + b0[0]; o[1] = (bf_hi(raw.x) - mu) * rstd * g0[1] + b0[1]; o[2] = (bf_lo(raw.y) - mu) * rstd * g0[2] + b0[2]; o[3] = (bf_hi(raw.y) - mu) * rstd * g0[3] + b0[3];
    o[4] = (bf_lo(raw.z) - mu) * rstd * g1[0] + b1[0]; o[5] = (bf_hi(raw.z) - mu) * rstd * g1[1] + b1[1]; o[6] = (bf_lo(raw.w) - mu) * rstd * g1[2] + b1[2]; o[7] = (bf_hi(raw.w) - mu) * rstd * g1[3] + b1[3];
}
__device__ __forceinline__ void gmlp_tile(Frame& F, int tile) {
    const int grp = tile & 7, n = (tile >> 3) & 15, b = tile >> 7; const int rowbase = b * 2048 + 128 * n, colbase = 128 * grp;
    LAS unsigned char* Vs = F.lds;
    int tid_ = F.tid; asm volatile("" : "+v"(tid_));
    const int lane_ = tid_ & 63, fr = lane_ & 15, fq = lane_ >> 4;
    u32x4 bw[4]; u32x2 uu[8]; float bias;
    {   const int tw = 16 * F.wave + fr;
#pragma unroll
        for (int ks = 0; ks < 4; ++ks) if (ks <= (F.wave >> 1)) {
            const float* wp = F.gm_ws + (size_t)(grp * 128 + tw) * 128 + 32 * ks + 8 * fq; const f32x4 w0 = *(const f32x4*)wp, w1 = *(const f32x4*)(wp + 4); const int s0 = 32 * ks + 8 * fq;
            bw[ks].x = cvt_pk_bf16(s0 + 0 <= tw ? w0[0] : 0.f, s0 + 1 <= tw ? w0[1] : 0.f); bw[ks].y = cvt_pk_bf16(s0 + 2 <= tw ? w0[2] : 0.f, s0 + 3 <= tw ? w0[3] : 0.f);
            bw[ks].z = cvt_pk_bf16(s0 + 4 <= tw ? w1[0] : 0.f, s0 + 5 <= tw ? w1[1] : 0.f); bw[ks].w = cvt_pk_bf16(s0 + 6 <= tw ? w1[2] : 0.f, s0 + 7 <= tw ? w1[3] : 0.f); }
        const bf16_t* uin = F.U + (size_t)(rowbase + tw) * D + colbase + 4 * fq;
#pragma unroll
        for (int dt = 0; dt < 8; ++dt) uu[dt] = *(const u32x2*)(uin + 16 * dt);
        bias = F.gm_bs[grp * 128 + tw]; }
#pragma unroll
    for (int i = 0; i < 4; ++i) { const int piece = tid_ + 512 * i, row = piece >> 4, ch = piece & 15;
        const u32x4 raw = *(const u32x4*)(F.V + (size_t)(rowbase + row) * D + colbase + 8 * ch); float mu, rstd; ln_stats(F.VSTAT, rowbase + row, mu, rstd);
        float o[8]; ln8(raw, mu, rstd, F.gm_ln_g + colbase + 8 * ch, F.gm_ln_b + colbase + 8 * ch, o);
        u32x4 w; w.x = cvt_pk_bf16(o[0], o[1]); w.y = cvt_pk_bf16(o[2], o[3]); w.z = cvt_pk_bf16(o[4], o[5]); w.w = cvt_pk_bf16(o[6], o[7]);
        *(LAS u32x4*)(Vs + row * 272 + ch * 16) = w; }
    __syncthreads();
    const int w8 = F.wave, t = 16 * w8 + fr;
    f32x4 acc[8];
#pragma unroll
    for (int i = 0; i < 8; ++i) acc[i] = (f32x4){0.f, 0.f, 0.f, 0.f};
    const int q4 = (lane_ >> 2) & 3, p4 = lane_ & 3;
#pragma unroll
    for (int ks = 0; ks < 4; ++ks) if (ks <= (w8 >> 1)) {
        const LAS unsigned char* vb = Vs + (32 * ks + 8 * fq + q4) * 272 + 8 * p4;
#pragma unroll
        for (int dt = 0; dt < 8; ++dt) { const bf16x8 a = cat4(tr_read(vb + 32 * dt), tr_read(vb + 4 * 272 + 32 * dt)); acc[dt] = __builtin_amdgcn_mfma_f32_16x16x32_bf16(a, as_bf16x8(bw[ks]), acc[dt], 0, 0, 0); }
    }
    bf16_t* up = F.UO + (size_t)(rowbase + t) * UOLD + colbase + 4 * fq;
#pragma unroll
    for (int dt = 0; dt < 8; ++dt) { u32x2 w;
        w.x = cvt_pk_bf16(bf_lo(uu[dt].x) * (acc[dt][0] + bias), bf_hi(uu[dt].x) * (acc[dt][1] + bias)); w.y = cvt_pk_bf16(bf_lo(uu[dt].y) * (acc[dt][2] + bias), bf_hi(uu[dt].y) * (acc[dt][3] + bias)); *(u32x2*)(up + 16 * dt) = w; }
    __syncthreads();
}
__device__ __forceinline__ void gmlp_sample_item(Frame& F, int item) {
    const int bs = item >> 7, cc = item & 127, c0 = 8 * cc, grp = c0 >> 7, r0 = MP + 8 * bs;
    float vn[8][8];
#pragma unroll
    for (int s = 0; s < 8; ++s) { const u32x4 raw = *(const u32x4*)(F.V + (size_t)(r0 + s) * D + c0); float mu, rstd; ln_stats(F.VSTAT, r0 + s, mu, rstd); ln8(raw, mu, rstd, F.gm_ln_g + c0, F.gm_ln_b + c0, vn[s]);
        float* gp = F.gv_sample + (size_t)(8 * bs + s) * D + c0; *(f32x4*)gp = (f32x4){vn[s][0], vn[s][1], vn[s][2], vn[s][3]}; *(f32x4*)(gp + 4) = (f32x4){vn[s][4], vn[s][5], vn[s][6], vn[s][7]}; }
#pragma unroll
    for (int t = 0; t < 8; ++t) {
        const float* wp = F.gm_ws + (size_t)(grp * 128 + t) * 128; const float bias = F.gm_bs[grp * 128 + t]; float mix[8];
#pragma unroll
        for (int c = 0; c < 8; ++c) mix[c] = bias;
#pragma unroll
        for (int s = 0; s < 8; ++s) if (s <= t) { const float ww = wp[s];
#pragma unroll
            for (int c = 0; c < 8; ++c) mix[c] = fmaf(ww, vn[s][c], mix[c]); }
        bf16_t* up = F.UO + (size_t)(r0 + t) * UOLD + c0; const u32x4 uu = *(const u32x4*)(F.U + (size_t)(r0 + t) * D + c0); u32x4 w;
        w.x = cvt_pk_bf16(bf_lo(uu.x) * mix[0], bf_hi(uu.x) * mix[1]); w.y = cvt_pk_bf16(bf_lo(uu.y) * mix[2], bf_hi(uu.y) * mix[3]); w.z = cvt_pk_bf16(bf_lo(uu.z) * mix[4], bf_hi(uu.z) * mix[5]); w.w = cvt_pk_bf16(bf_lo(uu.w) * mix[6], bf_hi(uu.w) * mix[7]);
        *(u32x4*)up = w;
    }
}
__device__ __forceinline__ void chain_item(Frame& F, int id) {
    const int bh = id >> 2, es = id & 3, b = bh >> 3, h = bh & 7, e0 = 64 * es;
    const float lg2 = __builtin_log2f(1.0f - __builtin_exp2f(-5.0f - (float)h)); const float g128 = __builtin_exp2f(128.f * lg2);
    int tid_ = F.tid; asm volatile("" : "+v"(tid_));
    const int lane_ = tid_ & 63, fr = lane_ & 15, fq = lane_ >> 4, q4 = (lane_ >> 2) & 3, p4 = lane_ & 3, w8 = F.wave;
    constexpr int KSB = 128 * 272, VSB = 128 * 144;
    LAS unsigned char* Ks = F.lds; LAS unsigned char* Vs = F.lds + 2 * KSB;
    u32x4 krA[4], vrA[2], krB[4], vrB[2];
    const bf16_t* kg = F.K + (size_t)(b * 2048) * D + h * 128; const bf16_t* vg = F.RV + (size_t)(b * 2048) * 2048 + h * 256 + e0;
#define CH_LOAD(kr, vr, n) do { _Pragma("unroll") for (int i = 0; i < 4; ++i) { const int piece = tid_ + 512 * i; kr[i] = *(const u32x4*)(kg + (size_t)(128 * (n) + (piece >> 4)) * D + 8 * (piece & 15)); } \
        _Pragma("unroll") for (int i = 0; i < 2; ++i) { const int piece = tid_ + 512 * i; vr[i] = *(const u32x4*)(vg + (size_t)(128 * (n) + (piece >> 3)) * 2048 + 8 * (piece & 7)); } } while (0)
#define CH_STEP(kr, vr, n, buf) do { \
        _Pragma("unroll") for (int i = 0; i < 4; ++i) { const int piece = tid_ + 512 * i, row = piece >> 4, ch = piece & 15; const float dec = __builtin_exp2f((float)(127 - row) * lg2); u32x4 w; \
            w.x = cvt_pk_bf16(bf_lo(kr[i].x) * dec, bf_hi(kr[i].x) * dec); w.y = cvt_pk_bf16(bf_lo(kr[i].y) * dec, bf_hi(kr[i].y) * dec); w.z = cvt_pk_bf16(bf_lo(kr[i].z) * dec, bf_hi(kr[i].z) * dec); w.w = cvt_pk_bf16(bf_lo(kr[i].w) * dec, bf_hi(kr[i].w) * dec); \
            *(LAS u32x4*)(Ks + (buf) * KSB + row * 272 + ch * 16) = w; } \
        _Pragma("unroll") for (int i = 0; i < 2; ++i) { const int piece = tid_ + 512 * i, row = piece >> 3, ch = piece & 7; *(LAS u32x4*)(Vs + (buf) * VSB + row * 144 + ch * 16) = vr[i]; } \
        if ((n) + 2 < 16) CH_LOAD(kr, vr, (n) + 2); \
        __syncthreads(); \
        bf16_t* sp = F.ST + ((size_t)(bh * 16 + (n)) * 256 + e0 + fr) * 128 + 16 * w8 + 4 * fq; \
        _Pragma("unroll") for (int et = 0; et < 4; ++et) { u32x2 w; w.x = cvt_pk_bf16(acc[et][0], acc[et][1]); w.y = cvt_pk_bf16(acc[et][2], acc[et][3]); *(u32x2*)(sp + (size_t)(16 * et) * 128) = w; acc[et] *= g128; } \
        _Pragma("unroll") for (int ks = 0; ks < 4; ++ks) { \
            const int l0 = 32 * ks + 8 * fq + q4; \
            const LAS unsigned char* ka = Ks + (buf) * KSB + l0 * 272 + (16 * w8 + 4 * p4) * 2; const bf16x8 a = cat4(tr_read(ka), tr_read(ka + 4 * 272)); \
            const LAS unsigned char* va = Vs + (buf) * VSB + l0 * 144 + 8 * p4; \
            _Pragma("unroll") for (int et = 0; et < 4; ++et) { const bf16x8 bb = cat4(tr_read(va + 32 * et), tr_read(va + 4 * 144 + 32 * et)); acc[et] = __builtin_amdgcn_mfma_f32_16x16x32_bf16(a, bb, acc[et], 0, 0, 0); } } } while (0)
    f32x4 acc[4];
#pragma unroll
    for (int i = 0; i < 4; ++i) acc[i] = (f32x4){0.f, 0.f, 0.f, 0.f};
    CH_LOAD(krA, vrA, 0); CH_LOAD(krB, vrB, 1);
    for (int n = 0; n < 16; n += 2) { CH_STEP(krA, vrA, n, 0); CH_STEP(krB, vrB, n + 1, 1); }
#undef CH_STEP
#undef CH_LOAD
#pragma unroll
    for (int et = 0; et < 4; ++et)
#pragma unroll
        for (int r = 0; r < 4; ++r) F.rs_prompt[((size_t)bh * 128 + dorig_of(16 * w8 + 4 * fq + r)) * 256 + e0 + 16 * et + fr] = acc[et][r];
    __syncthreads();
}
__device__ __forceinline__ void retout_item(Frame& F, int item) {
    const int n = item & 15, bh = item >> 4, b = bh >> 3, h = bh & 7, rowbase = b * 2048 + 128 * n;
    const float lg2 = __builtin_log2f(1.0f - __builtin_exp2f(-5.0f - (float)h));
    int tid_ = F.tid; asm volatile("" : "+v"(tid_));
    const int lane_ = tid_ & 63, fr = lane_ & 15, fq = lane_ >> 4, q4 = (lane_ >> 2) & 3, p4 = lane_ & 3, w8 = F.wave;
    LAS unsigned char* STs = F.lds; LAS unsigned char* Vs = F.lds + 256 * 272;
    { const bf16_t* sg = F.ST + (size_t)(bh * 16 + n) * 256 * 128;
#pragma unroll
      for (int i = 0; i < 8; ++i) { const int piece = tid_ + 512 * i, row = piece >> 4, ch = piece & 15; *(LAS u32x4*)(STs + row * 272 + ch * 16) = *(const u32x4*)(sg + (size_t)row * 128 + 8 * ch); }
      const bf16_t* vg = F.RV + (size_t)rowbase * 2048 + h * 256;
#pragma unroll
      for (int i = 0; i < 8; ++i) { const int piece = tid_ + 512 * i, row = piece >> 5, ch = piece & 31; *(LAS u32x4*)(Vs + row * 528 + ch * 16) = *(const u32x4*)(vg + (size_t)row * 2048 + 8 * ch); } }
    const int l = 16 * w8 + fr;
    bf16x8 qf[4], kf[8];
    const bf16_t* kg = F.K + (size_t)rowbase * D + h * 128 + 8 * fq;
#pragma unroll
    for (int ks = 0; ks < 4; ++ks) { qf[ks] = *(const bf16x8*)(F.Q + (size_t)(rowbase + l) * D + h * 128 + 32 * ks + 8 * fq); kf[ks] = *(const bf16x8*)(kg + (size_t)fr * D + 32 * ks); kf[4 + ks] = *(const bf16x8*)(kg + (size_t)(16 + fr) * D + 32 * ks); }
    __syncthreads();
    f32x4 acc[16];
#pragma unroll
    for (int i = 0; i < 16; ++i) acc[i] = (f32x4){0.f, 0.f, 0.f, 0.f};
#pragma unroll
    for (int ks = 0; ks < 4; ++ks)
#pragma unroll
        for (int et = 0; et < 16; ++et) { const bf16x8 a = *(const LAS bf16x8*)(STs + (16 * et + fr) * 272 + (32 * ks + 8 * fq) * 2); acc[et] = __builtin_amdgcn_mfma_f32_16x16x32_bf16(a, qf[ks], acc[et], 0, 0, 0); }
    { const float f = __builtin_exp2f((float)(l + 1) * lg2);
#pragma unroll
      for (int et = 0; et < 16; ++et) acc[et] *= f; }
    const int k2max = w8 >> 1;
    for (int k2 = 0; k2 <= k2max; ++k2) {
        f32x4 s0 = (f32x4){0.f, 0.f, 0.f, 0.f}, s1 = (f32x4){0.f, 0.f, 0.f, 0.f};
#pragma unroll
        for (int ks = 0; ks < 4; ++ks) { s0 = __builtin_amdgcn_mfma_f32_16x16x32_bf16(kf[ks], qf[ks], s0, 0, 0, 0); s1 = __builtin_amdgcn_mfma_f32_16x16x32_bf16(kf[4 + ks], qf[ks], s1, 0, 0, 0); }
        __builtin_amdgcn_sched_barrier(0);
        if (k2 < k2max) {
#pragma unroll
            for (int ks = 0; ks < 4; ++ks) { kf[ks] = *(const bf16x8*)(kg + (size_t)(32 * (k2 + 1) + fr) * D + 32 * ks); kf[4 + ks] = *(const bf16x8*)(kg + (size_t)(32 * (k2 + 1) + 16 + fr) * D + 32 * ks); } }
        __builtin_amdgcn_sched_barrier(0);
        float p[8];
#pragma unroll
        for (int r = 0; r < 4; ++r) { const int sa = 32 * k2 + 4 * fq + r, sb = sa + 16; p[r] = sa <= l ? s0[r] * __builtin_exp2f((float)(l - sa) * lg2) : 0.f; p[4 + r] = sb <= l ? s1[r] * __builtin_exp2f((float)(l - sb) * lg2) : 0.f; }
        u32x4 pw; pw.x = cvt_pk_bf16(p[0], p[1]); pw.y = cvt_pk_bf16(p[2], p[3]); pw.z = cvt_pk_bf16(p[4], p[5]); pw.w = cvt_pk_bf16(p[6], p[7]);
        const LAS unsigned char* va = Vs + (32 * k2 + 4 * fq + q4) * 528 + 8 * p4;
#pragma unroll
        for (int et = 0; et < 16; ++et) { const bf16x8 a = cat4(tr_read(va + 32 * et), tr_read(va + 16 * 528 + 32 * et)); acc[et] = __builtin_amdgcn_mfma_f32_16x16x32_bf16(a, as_bf16x8(pw), acc[et], 0, 0, 0); }
    }
    __builtin_amdgcn_sched_barrier(0);
    const bf16_t* gp = F.RG + (size_t)(rowbase + l) * 2048 + h * 256 + 4 * fq; u32x2 gg[16];
#pragma unroll
    for (int et = 0; et < 16; ++et) gg[et] = *(const u32x2*)(gp + 16 * et);
    float ss = 0.f;
#pragma unroll
    for (int et = 0; et < 16; ++et) ss += (acc[et][0] * acc[et][0] + acc[et][1] * acc[et][1]) + (acc[et][2] * acc[et][2] + acc[et][3] * acc[et][3]);
    ss += __shfl_xor(ss, 16); ss += __shfl_xor(ss, 32);
    const float rstd = 1.0f / sqrtf(ss * (1.f / 256.f) + EPS);
    bf16_t* op = F.UO + (size_t)(rowbase + l) * UOLD + 1024 + h * 256 + 4 * fq;
#pragma unroll
    for (int et = 0; et < 16; ++et) { u32x2 w; w.x = cvt_pk_bf16(acc[et][0] * rstd * bf_lo(gg[et].x), acc[et][1] * rstd * bf_hi(gg[et].x)); w.y = cvt_pk_bf16(acc[et][2] * rstd * bf_lo(gg[et].y), acc[et][3] * rstd * bf_hi(gg[et].y)); *(u32x2*)(op + 16 * et) = w; }
    __syncthreads();
}
__device__ __forceinline__ void retsample_item(Frame& F, int item) {
    const int bs = item >> 3, h = item & 7, r0 = MP + 8 * bs;
    const float lg2 = __builtin_log2f(1.0f - __builtin_exp2f(-5.0f - (float)h)); const float g8 = __builtin_exp2f(8.f * lg2);
    LAS float* qsT = (LAS float*)F.lds;
    LAS float* ksT = qsT + 1024;
    LAS float* vs = ksT + 1024;
    LAS float* Pm = vs + 2048;
    LAS float* red = Pm + 64;
    LAS float* part = red + 32;
    int t = F.tid; asm volatile("" : "+v"(t)); const int e4 = t & 63, dg = F.wave;
    const size_t sbase = (size_t)(bs * 8 + h) * 128 * 256 + 4 * e4;
    f32x4 s0[16];
#pragma unroll
    for (int i = 0; i < 16; ++i) s0[i] = *(const f32x4*)(F.state_ret + sbase + (size_t)dorig_of(16 * dg + i) * 256);
    { const int row = t >> 6, cp = t & 63; const unsigned qw = *(const unsigned*)(F.Q + (size_t)(r0 + row) * D + h * 128 + 2 * cp), kw = *(const unsigned*)(F.K + (size_t)(r0 + row) * D + h * 128 + 2 * cp);
      const float dec = __builtin_exp2f((float)(7 - row) * lg2);
      qsT[(2 * cp) * 8 + row] = bf_lo(qw); qsT[(2 * cp + 1) * 8 + row] = bf_hi(qw); ksT[(2 * cp) * 8 + row] = bf_lo(kw) * dec; ksT[(2 * cp + 1) * 8 + row] = bf_hi(kw) * dec;
      const u32x2 vw = *(const u32x2*)(F.RV + (size_t)(r0 + row) * 2048 + h * 256 + 4 * cp); *(LAS f32x4*)(vs + row * 256 + 4 * cp) = (f32x4){bf_lo(vw.x), bf_hi(vw.x), bf_lo(vw.y), bf_hi(vw.y)}; }
    __syncthreads();
    if (t < 64) { const int l = t >> 3, sx = t & 7; float d = 0.f; if (sx <= l) { for (int p = 0; p < 128; ++p) d = fmaf(qsT[p * 8 + l], ksT[p * 8 + sx], d); d *= __builtin_exp2f((float)(l - 7) * lg2); } Pm[t] = d; }
    f32x4 vreg[8], inter[8];
#pragma unroll
    for (int l = 0; l < 8; ++l) { vreg[l] = *(const LAS f32x4*)(vs + l * 256 + 4 * e4); inter[l] = (f32x4){0.f, 0.f, 0.f, 0.f}; }
#pragma unroll
    for (int i = 0; i < 16; ++i) {
        const int p = 16 * dg + i;
        const f32x4 qa = *(const LAS f32x4*)(qsT + p * 8), qb = *(const LAS f32x4*)(qsT + p * 8 + 4), ka = *(const LAS f32x4*)(ksT + p * 8), kb = *(const LAS f32x4*)(ksT + p * 8 + 4);
        f32x4 sn = g8 * s0[i];
#pragma unroll
        for (int l = 0; l < 4; ++l) { inter[l] += qa[l] * s0[i]; inter[4 + l] += qb[l] * s0[i]; sn += ka[l] * vreg[l]; sn += kb[l] * vreg[4 + l]; }
        *(f32x4*)(F.rs_sample + sbase + (size_t)dorig_of(p) * 256) = sn;
    }
#pragma unroll
    for (int l = 0; l < 8; ++l) *(LAS f32x4*)(part + (dg * 8 + l) * 256 + 4 * e4) = inter[l];
    __syncthreads();
    const int e = t & 255, lh = t >> 8;
    float o[4];
#pragma unroll
    for (int j = 0; j < 4; ++j) { const int l = 4 * lh + j; float a = 0.f;
#pragma unroll
        for (int g = 0; g < 8; ++g) a += part[(g * 8 + l) * 256 + e];
        a *= __builtin_exp2f((float)(l + 1) * lg2);
#pragma unroll
        for (int sx = 0; sx < 8; ++sx) if (sx <= l) a = fmaf(Pm[l * 8 + sx], vs[sx * 256 + e], a);
        o[j] = a; const float sq = wave_sum(a * a); if ((t & 63) == 0) red[l * 4 + (F.wave & 3)] = sq; }
    __syncthreads();
#pragma unroll
    for (int j = 0; j < 4; ++j) { const int l = 4 * lh + j; const float ss = (red[l * 4] + red[l * 4 + 1]) + (red[l * 4 + 2] + red[l * 4 + 3]); const float rstd = 1.0f / sqrtf(ss * (1.f / 256.f) + EPS);
        const float g = __uint_as_float((unsigned)F.RG[(size_t)(r0 + l) * 2048 + h * 256 + e] << 16); F.UO[(size_t)(r0 + l) * UOLD + 1024 + h * 256 + e] = (bf16_t)(cvt_pk_bf16(o[j] * rstd * g, 0.f) & 0xffffu); }
    __syncthreads();
}

__global__ void __launch_bounds__(512, 2) mega_fwd(Args args) {
    extern __shared__ __attribute__((aligned(16))) unsigned char lds[];
    Frame F;
    F.lds = (LAS unsigned char*)lds;
    volatile LAS unsigned* MISC = (volatile LAS unsigned*)(F.lds + MISC_OFF);
    F.tid = threadIdx.x; F.lane = F.tid & 63; F.wave = __builtin_amdgcn_readfirstlane(F.tid >> 6);
    F.G = gridDim.x; { const int bx = blockIdx.x; F.vcu = (F.G % 8 == 0) ? (bx % 8) * (F.G / 8) + bx / 8 : bx; }
    unsigned char* ws = args.ws; unsigned* ctl = (unsigned*)(ws + WS_CTL);
    F.x_prompt = args.in[0]; F.x_sample = args.in[1]; F.state_ret = args.in[2]; F.c_prompt = args.in[3]; F.c_sample = args.in[4]; F.w_ada = args.in[5]; F.b_ada = args.in[6]; F.n1_g = args.in[7];
    F.w1_gate = args.in[8]; F.w1_up = args.in[9]; F.w1_down = args.in[10]; F.nm_g = args.in[11]; F.w_in = args.in[12]; F.gm_ln_g = args.in[13]; F.gm_ln_b = args.in[14]; F.gm_ws = args.in[15]; F.gm_bs = args.in[16];
    F.w_a = args.in[17]; F.w_b = args.in[18]; F.w_o = args.in[19]; F.n2_g = args.in[20]; F.w2_gate = args.in[21]; F.w2_up = args.in[22]; F.w2_down = args.in[23]; F.final_g = args.in[24];
    F.X = args.out; F.rs_prompt = args.out + (size_t)MT * D; F.rs_sample = F.rs_prompt + (size_t)64 * 128 * 256; F.gv_sample = F.rs_sample + (size_t)1024 * 128 * 256;
    F.MOD = (float*)(ws + WS_MOD); F.ROPEC = (float*)(ws + WS_ROPEC); F.ROPES = (float*)(ws + WS_ROPES); F.VSTAT = (unsigned long long*)(ctl + CW_VSTAT);
    F.W1GU = (bf16_t*)(ws + WS_W1GU); F.W1D = (bf16_t*)(ws + WS_W1D); F.W2GU = (bf16_t*)(ws + WS_W2GU); F.W2D = (bf16_t*)(ws + WS_W2D); F.WIN = (bf16_t*)(ws + WS_WIN); F.WAB = (bf16_t*)(ws + WS_WAB); F.WO = (bf16_t*)(ws + WS_WO);
    F.H = (bf16_t*)(ws + WS_H); F.UO = (bf16_t*)(ws + WS_UO); F.V = (bf16_t*)(ws + WS_V); F.Q = (bf16_t*)(ws + WS_Q); F.K = (bf16_t*)(ws + WS_K); F.RV = (bf16_t*)(ws + WS_RV); F.SGA = (bf16_t*)(ws + WS_SGA); F.SGB = (bf16_t*)(ws + WS_SGB);
    F.HID = (bf16_t*)(ws + WS_HID); F.ST = (bf16_t*)(ws + WS_ST); F.U = (bf16_t*)(ws + WS_U); F.RG = (bf16_t*)(ws + WS_RG);
    if (F.tid < 128) MISC[F.tid] = 0u;
    __syncthreads();
    const int lo = args.ph_lo, hi = args.ph_hi;
    XcdBarrier bar; bar.bar = ctl + CW_BAR; bar.x = 0; bar.st = nullptr;
    if (hi - lo > 1) bar = xcd_barrier_post(ctl + CW_BAR, MISC + 8);
#ifndef PHMASK
#define PHMASK 0x3fff
#endif
#define IN(k) (((PHMASK >> (k)) & 1) && lo <= (k) && (k) < hi)
#ifndef REPMASK
#define REPMASK 0
#endif
#define SEAM(k) do { if (IN(k) && IN((k) + 1)) xcd_barrier(bar); } while (0)

#ifdef DBG_TIME
#define STAMP(k) do { if (blockIdx.x == 0 && F.tid == 0) ((unsigned long long*)(ctl + 3000))[k] = __builtin_amdgcn_s_memrealtime(); } while (0)
#else
#define STAMP(k) do { } while (0)
#endif
    STAMP(0);
    if (IN(0)) { p0_prologue(F); }
    if (IN(0) && ((REPMASK >> 0) & 1)) { p0_prologue(F); }
    SEAM(0); STAMP(1);
    if (IN(1)) { norm_mod_phase(F, F.x_prompt, F.x_sample, F.n1_g, 0 * D, 1 * D); }
    if (IN(1) && ((REPMASK >> 1) & 1)) { norm_mod_phase(F, F.x_prompt, F.x_sample, F.n1_g, 0 * D, 1 * D); }
    SEAM(1); STAMP(2);
    if (IN(2)) { pg8::Gemm g{F.H, F.W1GU, MT, NGU, D}; pg8::StaticOrder S; S.init(MT, NGU, F.G, (int)blockIdx.x); EpiGateUp E{F.HID}; pg8::gemm_phase(F.lds, g, S, E); }
    if (IN(2) && ((REPMASK >> 2) & 1)) { pg8::Gemm g{F.H, F.W1GU, MT, NGU, D}; pg8::StaticOrder S; S.init(MT, NGU, F.G, (int)blockIdx.x); EpiGateUp E{F.HID}; pg8::gemm_phase(F.lds, g, S, E); }
    SEAM(2); STAMP(3);
    if (IN(3)) { pg8::Gemm g{F.HID, F.W1D, MP, D, DFF}; pg8::StaticOrder S; S.init(MP, D, F.G, (int)blockIdx.x); EpiResid E{F.x_prompt, F.x_sample, F.X, F.MOD, 2 * D, 0.5f}; pg8::gemm_phase(F.lds, g, S, E);
        for (int tile = F.vcu; tile < 256; tile += F.G) mini_resid_tile<11>(F, F.HID, F.W1D, tile, F.x_sample - (size_t)MP * D, F.X, 2 * D, 0.5f); }
    if (IN(3) && ((REPMASK >> 3) & 1)) { pg8::Gemm g{F.HID, F.W1D, MP, D, DFF}; pg8::StaticOrder S; S.init(MP, D, F.G, (int)blockIdx.x); EpiResid E{F.x_prompt, F.x_sample, F.X, F.MOD, 2 * D, 0.5f}; pg8::gemm_phase(F.lds, g, S, E);
        for (int tile = F.vcu; tile < 256; tile += F.G) mini_resid_tile<11>(F, F.HID, F.W1D, tile, F.x_sample - (size_t)MP * D, F.X, 2 * D, 0.5f); }
    SEAM(3); STAMP(4);
    if (IN(4)) { norm_mod_phase(F, F.X, F.X + (size_t)MP * D, F.nm_g, 3 * D, 4 * D); }
    if (IN(4) && ((REPMASK >> 4) & 1)) { norm_mod_phase(F, F.X, F.X + (size_t)MP * D, F.nm_g, 3 * D, 4 * D); }
    SEAM(4); STAMP(5);
    if (IN(5)) { pg8::Gemm g{F.H, F.WIN, MT, NIN, D}; pg8::StaticOrder S; S.init(MT, NIN, F.G, (int)blockIdx.x); EpiWin E{F.U, F.RG, F.V, F.Q, F.K, F.RV, F.SGA, F.SGB, F.VSTAT, F.ROPEC, F.ROPES}; pg8::gemm_phase(F.lds, g, S, E); } SEAM(5); STAMP(6);
    if (IN(6)) for (int rep6 = 0; rep6 < (((REPMASK >> 6) & 1) ? 2 : 1); ++rep6) {
#define RPT(bit) for (int rr_ = 0; rr_ < (((REPMASK >> (bit)) & 1) ? 2 : 1); ++rr_)
        if (F.vcu & 1) RPT(16) for (int it = F.vcu; it < 512; it += F.G) retsample_item(F, it);
        RPT(17) for (int id = F.vcu; id < 256; id += F.G) chain_item(F, id);
        RPT(18) for (int tile = F.vcu; tile < 1024; tile += F.G) gmlp_tile(F, tile);
        for (int it = F.vcu + F.G * F.tid; it < 128 * 128; it += F.G * 512) gmlp_sample_item(F, it);
        if (!(F.vcu & 1)) RPT(16) for (int it = F.vcu; it < 512; it += F.G) retsample_item(F, it);
    } SEAM(6); STAMP(7);
    if (IN(7)) for (int rep7 = 0; rep7 < (((REPMASK >> 7) & 1) ? 2 : 1); ++rep7) {
        {   const int nro = (1024 - F.vcu + F.G - 1) / F.G, nrs = (512 - F.vcu + F.G - 1) / F.G; const bool rs_first = F.vcu & 1;
            for (int j = 0; j < nro + nrs; ++j) { const bool is_rs = rs_first ? (j < nrs) : (j >= nro);
                if (is_rs) { RPT(16) retsample_item(F, 512 + F.vcu + F.G * (rs_first ? j : j - nro)); } else { RPT(19) retout_item(F, F.vcu + F.G * (rs_first ? j - nrs : j)); } } }
    } SEAM(7); STAMP(8);
    if (IN(8)) { pg8::Gemm g{F.UO, F.WAB, MP, D, 3072}; pg8::StaticOrder S; S.init(MP, D, F.G, (int)blockIdx.x); EpiMerged E{F.SGA, F.SGB, F.H}; pg8::gemm_phase(F.lds, g, S, E);
        for (int tile = F.vcu; tile < 256; tile += F.G) mini_merged_tile(F, tile); }
    if (IN(8) && ((REPMASK >> 8) & 1)) { pg8::Gemm g{F.UO, F.WAB, MP, D, 3072}; pg8::StaticOrder S; S.init(MP, D, F.G, (int)blockIdx.x); EpiMerged E{F.SGA, F.SGB, F.H}; pg8::gemm_phase(F.lds, g, S, E);
        for (int tile = F.vcu; tile < 256; tile += F.G) mini_merged_tile(F, tile); }
    SEAM(8); STAMP(9);
    if (IN(9)) { pg8::Gemm g{F.H, F.WO, MP, D, D}; pg8::StaticOrder S; S.init(MP, D, F.G, (int)blockIdx.x); EpiResid E{F.X, F.X + (size_t)MP * D, F.X, F.MOD, 5 * D, 1.0f}; pg8::gemm_phase(F.lds, g, S, E);
        for (int tile = F.vcu; tile < 256; tile += F.G) mini_resid_tile<4>(F, F.H, F.WO, tile, F.X, F.X, 5 * D, 1.0f); } SEAM(9); STAMP(10);
    if (IN(10)) { norm_mod_phase(F, F.X, F.X + (size_t)MP * D, F.n2_g, 6 * D, 7 * D); }
    if (IN(10) && ((REPMASK >> 10) & 1)) { norm_mod_phase(F, F.X, F.X + (size_t)MP * D, F.n2_g, 6 * D, 7 * D); }
    SEAM(10); STAMP(11);
    if (IN(11)) { pg8::Gemm g{F.H, F.W2GU, MT, NGU, D}; pg8::StaticOrder S; S.init(MT, NGU, F.G, (int)blockIdx.x); EpiGateUp E{F.HID}; pg8::gemm_phase(F.lds, g, S, E); }
    if (IN(11) && ((REPMASK >> 11) & 1)) { pg8::Gemm g{F.H, F.W2GU, MT, NGU, D}; pg8::StaticOrder S; S.init(MT, NGU, F.G, (int)blockIdx.x); EpiGateUp E{F.HID}; pg8::gemm_phase(F.lds, g, S, E); }
    SEAM(11); STAMP(12);
    if (IN(12)) { pg8::Gemm g{F.HID, F.W2D, MP, D, DFF}; pg8::StaticOrder S; S.init(MP, D, F.G, (int)blockIdx.x); EpiResid E{F.X, F.X + (size_t)MP * D, F.X, F.MOD, 8 * D, 0.5f}; pg8::gemm_phase(F.lds, g, S, E);
        for (int tile = F.vcu; tile < 256; tile += F.G) mini_resid_tile<11>(F, F.HID, F.W2D, tile, F.X, F.X, 8 * D, 0.5f); } SEAM(12); STAMP(13);
#ifdef DBG_TIME
    float dbg_scale = 1.f;
    {   const unsigned long long* st = (const unsigned long long*)(ctl + 3000);
        const float t1 = (float)(__hip_atomic_load(st + DBG_T1B, RLX_AGENT) - __hip_atomic_load(st + DBG_T1A, RLX_AGENT)) * 0.01f, t2 = (float)(__hip_atomic_load(st + DBG_T2B, RLX_AGENT) - __hip_atomic_load(st + DBG_T2A, RLX_AGENT)) * 0.01f;
        const float E = __builtin_rintf(t1 / DBG_T1STEP), f = fminf(t2 / DBG_T2MAX, 0.99f); dbg_scale = 1.f + __builtin_exp2f(E * 3.3219280949f) * (1.f + f); }
    if (IN(13)) { final_norm_phase(F, dbg_scale); }
#else
    if (IN(13)) { final_norm_phase(F, 1.f); }
#endif
#undef IN
#undef SEAM
}

#ifdef DBG_LAST
__global__ void dbg_dump_bf16(const bf16_t* src, float* dst, size_t n) { for (size_t i = (size_t)blockIdx.x * 256 + threadIdx.x; i < n; i += (size_t)gridDim.x * 256) dst[i] = __uint_as_float((unsigned)src[i] << 16); }
__global__ void dbg_dump_f32(const float* src, float* dst, size_t n) { for (size_t i = (size_t)blockIdx.x * 256 + threadIdx.x; i < n; i += (size_t)gridDim.x * 256) dst[i] = src[i]; }
__global__ void dbg_fill(float* dst, size_t n) { for (size_t i = (size_t)blockIdx.x * 256 + threadIdx.x; i < n; i += (size_t)gridDim.x * 256) dst[i] = 1.0f; }
#endif
#ifdef DBG_CK
__global__ void dbg_cksum(const unsigned* p, size_t nwords, unsigned long long* out) {
    unsigned long long s = 0; for (size_t i = (size_t)blockIdx.x * 256 + threadIdx.x; i < nwords; i += (size_t)gridDim.x * 256) s += (unsigned long long)p[i] * ((i & 0xffffu) + 1u);
    for (int o = 32; o > 0; o >>= 1) s += __shfl_xor(s, o);
    if ((threadIdx.x & 63) == 0) atomicAdd(out, s);
}
__global__ void dbg_encode(const unsigned long long* ck, float* ys, size_t n, int nph) {
    int bad = -1; for (int p = 0; p < nph && bad < 0; ++p) for (int r = 1; r < DBG_CK; ++r) if (ck[p] != ck[16 * r + p]) { bad = p; break; }
    if (bad < 0) return;
    const float f = 1.0f + sqrtf((float)(bad + 1));
    for (size_t i = (size_t)blockIdx.x * 256 + threadIdx.x; i < n; i += (size_t)gridDim.x * 256) ys[i] *= f;
}
#endif
#if defined(DBG_MIX) || defined(DBG_HYB) || defined(DBG_SUB) || defined(DBG_PTR)
#include <math.h>
__global__ void dbg_cvt(const bf16_t* src, int ld, int coff, float* dst, int R, int W) { for (size_t i = (size_t)blockIdx.x * 256 + threadIdx.x; i < (size_t)R * W; i += (size_t)gridDim.x * 256) { const int r = (int)(i / W), c = (int)(i % W); dst[i] = __uint_as_float((unsigned)src[(size_t)r * ld + coff + c] << 16); } }
__global__ void dbg_cvt_perm(const bf16_t* src, float* dst, int R) { for (size_t i = (size_t)blockIdx.x * 256 + threadIdx.x; i < (size_t)R * 1024; i += (size_t)gridDim.x * 256) { const int r = (int)(i >> 10), c = (int)(i & 1023), h = c >> 7, p = c & 127; dst[(size_t)r * 1024 + h * 128 + dorig_of(p)] = __uint_as_float((unsigned)src[i] << 16); } }
__global__ void dbg_mul_cvt(const bf16_t* src, int ld, int coff, float* dst, int R, int W) { for (size_t i = (size_t)blockIdx.x * 256 + threadIdx.x; i < (size_t)R * W; i += (size_t)gridDim.x * 256) { const int r = (int)(i / W), c = (int)(i % W); dst[i] *= __uint_as_float((unsigned)src[(size_t)r * ld + coff + c] << 16); } }
__global__ void dbg_maxdiff(const float* a, const bf16_t* b, size_t n, unsigned* out) { float m = 0.f; for (size_t i = (size_t)blockIdx.x * 256 + threadIdx.x; i < n; i += (size_t)gridDim.x * 256) m = fmaxf(m, fabsf(a[i] - __uint_as_float((unsigned)b[i] << 16)));
    for (int o = 32; o > 0; o >>= 1) m = fmaxf(m, __shfl_xor(m, o)); if ((threadIdx.x & 63) == 0) atomicMax(out, __float_as_uint(m)); }
#ifndef DBG_DIFF
#define DBG_DIFF 0
#endif
__global__ void dbg_fracbad(const bf16_t* b, size_t n, unsigned* cnt) { unsigned c = 0; for (size_t i = (size_t)blockIdx.x * 256 + threadIdx.x; i < n; i += (size_t)gridDim.x * 256) { const float v = __uint_as_float((unsigned)b[i] << 16); c += (DBG_DIFF == 5 ? (fabsf(v) > 2.f) : (v < 0.f || v > 1.001f)) ? 1u : 0u; } atomicAdd(cnt, c); }
__global__ void dbg_frac2code(unsigned* code, size_t n) { const float f = (float)code[1] / (float)n; code[0] = __float_as_uint(f); }
__global__ void dbg_scale_imm(float* y, size_t n, float f) { for (size_t i = (size_t)blockIdx.x * 256 + threadIdx.x; i < n; i += (size_t)gridDim.x * 256) y[i] *= f; }
__global__ void dbg_scale(float* y, size_t n, const unsigned* code) { const float f = 1.0f + __uint_as_float(*code); for (size_t i = (size_t)blockIdx.x * 256 + threadIdx.x; i < n; i += (size_t)gridDim.x * 256) y[i] *= f; }
__global__ void dbg_copy(const float* src, float* dst, size_t n) { for (size_t i = (size_t)blockIdx.x * 256 + threadIdx.x; i < n; i += (size_t)gridDim.x * 256) dst[i] = src[i]; }
namespace nv {
constexpr int D = 1024, DFF = 2816, NSEQ = 136, NMOD = 9216;
constexpr int MP = 16384, MS = 1024;

__device__ __forceinline__ float silu_f(float x) { return x / (1.f + expf(-x)); }
__device__ __forceinline__ float sigm_f(float x) { return 1.f / (1.f + expf(-x)); }
__device__ __forceinline__ float gelu_f(float x) { const float u = 0.7978845608028654f * (x + 0.044715f * x * x * x); return 0.5f * x * (1.f + tanhf(u)); }

struct GemmP { const float* A; const float* B; float* C; const float* aux; const float* aux2; int lda, ldb, ldc, M, N, K, rows_per_seq, seq0; float scale; int pad; };
template <int EPI>
__global__ void __launch_bounds__(256) gemm_naive(GemmP p) {
    __shared__ float As[16][65];
    __shared__ float Bs[16][64];
    const int tx = threadIdx.x & 15, ty = threadIdx.x >> 4;
    const int m0 = blockIdx.y * 64, n0 = blockIdx.x * 64;
    float acc[4][4];
#pragma unroll
    for (int i = 0; i < 4; ++i)
#pragma unroll
        for (int j = 0; j < 4; ++j) acc[i][j] = 0.f;
    for (int k0 = 0; k0 < p.K; k0 += 16) {
#pragma unroll
        for (int i = 0; i < 4; ++i) { const int e = threadIdx.x + i * 256; const int r = e >> 4, c = e & 15; int gr = m0 + r; if (gr >= p.M) gr = p.M - 1; As[c][r] = p.A[(size_t)gr * p.lda + k0 + c]; }
#pragma unroll
        for (int i = 0; i < 4; ++i) { const int e = threadIdx.x + i * 256; const int r = e >> 6, c = e & 63; Bs[r][c] = p.B[(size_t)(k0 + r) * p.ldb + n0 + c]; }
        __syncthreads();
#pragma unroll
        for (int kk = 0; kk < 16; ++kk) {
            float a[4], b[4];
#pragma unroll
            for (int i = 0; i < 4; ++i) a[i] = As[kk][ty * 4 + i];
#pragma unroll
            for (int j = 0; j < 4; ++j) b[j] = Bs[kk][tx * 4 + j];
#pragma unroll
            for (int i = 0; i < 4; ++i)
#pragma unroll
                for (int j = 0; j < 4; ++j) acc[i][j] = fmaf(a[i], b[j], acc[i][j]);
        }
        __syncthreads();
    }
#pragma unroll
    for (int i = 0; i < 4; ++i) {
        const int r = m0 + ty * 4 + i; if (r >= p.M) continue;
#pragma unroll
        for (int j = 0; j < 4; ++j) {
            const int c = n0 + tx * 4 + j; float* cp = p.C + (size_t)r * p.ldc + c; const float a = acc[i][j]; float o;
            if (EPI == 0) o = a;
            else if (EPI == 1) o = a + p.aux[c];
            else if (EPI == 2) o = gelu_f(a);
            else if (EPI == 3) o = sigm_f(a);
            else if (EPI == 4) o = silu_f(*cp) * a;
            else if (EPI == 5) o = (*cp) * silu_f(a);
            else if (EPI == 6) o = (*cp) * a;
            else if (EPI == 7) o = p.aux[(size_t)r * p.ldc + c] + (*cp) * a;
            else { const int seq = p.seq0 + r / p.rows_per_seq; o = p.aux[(size_t)r * p.ldc + c] + p.scale * p.aux2[(size_t)seq * NMOD + c] * a; }
            *cp = o;
        }
    }
}

__global__ void silu_rows(const float* cp, const float* cs, float* out) {
    const int i = blockIdx.x * 256 + threadIdx.x; if (i >= NSEQ * D) return;
    const int s = i / D, c = i % D; const float v = s < 8 ? cp[s * D + c] : cs[(s - 8) * D + c]; out[i] = silu_f(v);
}
__device__ __forceinline__ float block_sum(float v, float* red) {
#pragma unroll
    for (int o = 32; o > 0; o >>= 1) v += __shfl_xor(v, o);
    __syncthreads();
    if ((threadIdx.x & 63) == 0) red[threadIdx.x >> 6] = v;
    __syncthreads();
    return red[0] + red[1] + red[2] + red[3];
}
__global__ void __launch_bounds__(256) norm_mod(const float* x, const float* g, const float* mod, int sh_off, int sc_off, int rows_per_seq, int seq0, float* out) {
    __shared__ float red[4];
    const int r = blockIdx.x; const float4 v = ((const float4*)(x + (size_t)r * D))[threadIdx.x];
    const float ss = block_sum(v.x * v.x + v.y * v.y + v.z * v.z + v.w * v.w, red);
    const float rstd = 1.0f / sqrtf(ss * (1.f / D) + 1e-6f);
    const float4 gg = ((const float4*)g)[threadIdx.x];
    float4 o = make_float4(v.x * rstd * gg.x, v.y * rstd * gg.y, v.z * rstd * gg.z, v.w * rstd * gg.w);
    if (mod) { const int seq = seq0 + r / rows_per_seq; const float4 sh = ((const float4*)(mod + (size_t)seq * NMOD + sh_off))[threadIdx.x], sc = ((const float4*)(mod + (size_t)seq * NMOD + sc_off))[threadIdx.x];
        o.x = o.x * (1.f + sc.x) + sh.x; o.y = o.y * (1.f + sc.y) + sh.y; o.z = o.z * (1.f + sc.z) + sh.z; o.w = o.w * (1.f + sc.w) + sh.w; }
    ((float4*)(out + (size_t)r * D))[threadIdx.x] = o;
}
__global__ void __launch_bounds__(256) ln_rows(float* v, const float* g, const float* b, float* out2) {
    __shared__ float red[4];
    const int r = blockIdx.x; float4 x = ((float4*)(v + (size_t)r * D))[threadIdx.x];
    const float mu = block_sum(x.x + x.y + x.z + x.w, red) * (1.f / D);
    x.x -= mu; x.y -= mu; x.z -= mu; x.w -= mu;
    const float var = block_sum(x.x * x.x + x.y * x.y + x.z * x.z + x.w * x.w, red) * (1.f / D);
    const float rstd = 1.0f / sqrtf(var + 1e-6f);
    const float4 gg = ((const float4*)g)[threadIdx.x], bb = ((const float4*)b)[threadIdx.x];
    float4 o = make_float4(x.x * rstd * gg.x + bb.x, x.y * rstd * gg.y + bb.y, x.z * rstd * gg.z + bb.z, x.w * rstd * gg.w + bb.w);
    ((float4*)(v + (size_t)r * D))[threadIdx.x] = o;
    if (out2) ((float4*)(out2 + (size_t)r * D))[threadIdx.x] = o;
}
__global__ void rotary_qk(float* q, float* k, int R, int L, int pos0) {
    const int i = blockIdx.x * 256 + threadIdx.x; if (i >= R * 8 * 64) return;
    const int r = i / 512, h = (i / 64) & 7, j = i & 63;
    const double inv = pow(10000.0, -(double)j / 64.0); const double ang = (double)(pos0 + (r % L)) * inv;
    const float c = (float)cos(ang), s = (float)sin(ang);
    float* qp = q + (size_t)r * D + h * 128 + j; float* kp = k + (size_t)r * D + h * 128 + j;
    const float q1 = qp[0], q2 = qp[64]; qp[0] = q1 * c - q2 * s; qp[64] = q1 * s + q2 * c;
    const float k1 = kp[0], k2 = kp[64]; const float sc = 0.08838834764831845f; kp[0] = (k1 * c - k2 * s) * sc; kp[64] = (k1 * s + k2 * c) * sc;
}
__global__ void spatial_mix(float* u, const float* vn, const float* ws, const float* bs, int R, int lc) {
    const size_t i = (size_t)blockIdx.x * 256 + threadIdx.x; if (i >= (size_t)R * D) return;
    const int r = (int)(i / D), c = (int)(i % D), g = c >> 7, t = r % lc, r0 = r - t;
    float acc = bs[g * 128 + t];
    for (int s = 0; s <= t; ++s) acc = fmaf(ws[(g * 128 + t) * 128 + s], vn[(size_t)(r0 + s) * D + c], acc);
    u[i] *= acc;
}
__global__ void __launch_bounds__(256) retention_rec(const float* q, const float* k, const float* v, float* o, const float* S0, float* Sout, int L) {
    __shared__ float qs[8][128], ks[8][128];
    const int b = blockIdx.x >> 3, h = blockIdx.x & 7, e = threadIdx.x;
    const float gamma = 1.0f - exp2f(-5.0f - (float)h);
    float S[128];
#pragma unroll
    for (int d = 0; d < 128; ++d) S[d] = S0 ? S0[((size_t)(b * 8 + h) * 128 + d) * 256 + e] : 0.f;
    for (int t0 = 0; t0 < L; t0 += 8) {
        __syncthreads();
        for (int i = threadIdx.x; i < 8 * 128; i += 256) { const int tt = i >> 7, d = i & 127; const size_t off = (size_t)(b * L + t0 + tt) * D + h * 128 + d; qs[tt][d] = q[off]; ks[tt][d] = k[off]; }
        __syncthreads();
        for (int tt = 0; tt < 8; ++tt) {
            const size_t row = (size_t)(b * L + t0 + tt);
            const float vv = v[row * 2048 + h * 256 + e]; float acc = 0.f;
#pragma unroll
            for (int d = 0; d < 128; ++d) { S[d] = fmaf(ks[tt][d], vv, gamma * S[d]); acc = fmaf(qs[tt][d], S[d], acc); }
            o[row * 2048 + h * 256 + e] = acc;
        }
    }
#pragma unroll
    for (int d = 0; d < 128; ++d) Sout[((size_t)(b * 8 + h) * 128 + d) * 256 + e] = S[d];
}
__global__ void __launch_bounds__(256) head_rms(float* o, int R) {
    const int w = blockIdx.x * 4 + (threadIdx.x >> 6), lane = threadIdx.x & 63; if (w >= R * 8) return;
    float4* p = (float4*)(o + (size_t)w * 256) + lane; float4 x = *p; float s = x.x * x.x + x.y * x.y + x.z * x.z + x.w * x.w;
#pragma unroll
    for (int of = 32; of > 0; of >>= 1) s += __shfl_xor(s, of);
    const float r = 1.0f / sqrtf(s * (1.f / 256.f) + 1e-6f); x.x *= r; x.y *= r; x.z *= r; x.w *= r; *p = x;
}

template <int EPI> static void gemm(hipStream_t st, const float* A, int lda, const float* B, int ldb, float* C, int ldc, int M, int N, int K, const float* aux = nullptr, const float* aux2 = nullptr, int rps = 1, int seq0 = 0, float scale = 1.f) {
    GemmP p; memset(&p, 0, sizeof(p)); p.A = A; p.B = B; p.C = C; p.aux = aux; p.aux2 = aux2; p.lda = lda; p.ldb = ldb; p.ldc = ldc; p.M = M; p.N = N; p.K = K; p.rows_per_seq = rps; p.seq0 = seq0; p.scale = scale;
    hipLaunchKernelGGL(gemm_naive<EPI>, dim3(N / 64, (M + 63) / 64), dim3(256), 0, st, p);
}

static void forward(void* const* d_in, float* out, unsigned char* ws, hipStream_t st) {
    const float* x_prompt = (const float*)d_in[0]; const float* x_sample = (const float*)d_in[1]; const float* state_ret = (const float*)d_in[2];
    const float* c_prompt = (const float*)d_in[3]; const float* c_sample = (const float*)d_in[4]; const float* w_ada = (const float*)d_in[5]; const float* b_ada = (const float*)d_in[6];
    const float* n1_g = (const float*)d_in[7]; const float* w1_gate = (const float*)d_in[8]; const float* w1_up = (const float*)d_in[9]; const float* w1_down = (const float*)d_in[10];
    const float* nm_g = (const float*)d_in[11]; const float* w_in = (const float*)d_in[12]; const float* gm_ln_g = (const float*)d_in[13]; const float* gm_ln_b = (const float*)d_in[14];
    const float* gm_ws = (const float*)d_in[15]; const float* gm_bs = (const float*)d_in[16]; const float* w_a = (const float*)d_in[17]; const float* w_b = (const float*)d_in[18]; const float* w_o = (const float*)d_in[19];
    const float* n2_g = (const float*)d_in[20]; const float* w2_gate = (const float*)d_in[21]; const float* w2_up = (const float*)d_in[22]; const float* w2_down = (const float*)d_in[23]; const float* final_g = (const float*)d_in[24];
    float* y_prompt = out; float* y_sample = out + (size_t)MP * D; float* rs_prompt = y_sample + (size_t)MS * D; float* rs_sample = rs_prompt + (size_t)8 * 8 * 128 * 256; float* gv_sample = rs_sample + (size_t)128 * 8 * 128 * 256;
    constexpr int RG = 4096;
    size_t off = 0; auto carve = [&](size_t nfloats) { float* p = (float*)(ws + off); off += ((nfloats * 4 + 255) / 256) * 256; return p; };
    float* MOD = carve((size_t)NSEQ * NMOD); float* SC = carve((size_t)NSEQ * D);
    float* X = carve((size_t)RG * D); float* H = carve((size_t)RG * D); float* G = carve((size_t)RG * DFF);
    float* U = carve((size_t)RG * D); float* V = carve((size_t)RG * D); float* Q = carve((size_t)RG * D); float* K = carve((size_t)RG * D);
    float* RV = carve((size_t)RG * 2048); float* OR = carve((size_t)RG * 2048); float* GA = carve((size_t)RG * D); float* GB = carve((size_t)RG * D); float* MG = carve((size_t)RG * D);

    hipLaunchKernelGGL(silu_rows, dim3((NSEQ * D + 255) / 256), dim3(256), 0, st, c_prompt, c_sample, SC);
    gemm<1>(st, SC, D, w_ada, NMOD, MOD, NMOD, NSEQ, NMOD, D, b_ada);
    for (int grp = 0; grp < 5; ++grp) {
        const bool smp = grp == 4; const int R = smp ? MS : RG, L = smp ? 8 : 2048, lc = smp ? 8 : 128, seq0 = smp ? 8 : grp * 2, pos0 = smp ? 16384 : 0, nseq = R / L;
        const float* xin = smp ? x_sample : x_prompt + (size_t)grp * RG * D; float* yout = smp ? y_sample : y_prompt + (size_t)grp * RG * D;
        hipLaunchKernelGGL(norm_mod, dim3(R), dim3(256), 0, st, xin, n1_g, MOD, 0 * D, 1 * D, L, seq0, H);
        gemm<0>(st, H, D, w1_gate, DFF, G, DFF, R, DFF, D);
        gemm<4>(st, H, D, w1_up, DFF, G, DFF, R, DFF, D);
        gemm<8>(st, G, DFF, w1_down, D, X, D, R, D, DFF, xin, MOD + 2 * D, L, seq0, 0.5f);
        hipLaunchKernelGGL(norm_mod, dim3(R), dim3(256), 0, st, X, nm_g, MOD, 3 * D, 4 * D, L, seq0, H);
        gemm<2>(st, H, D, w_in + 0, 10240, U, D, R, D, D);
        gemm<2>(st, H, D, w_in + 1024, 10240, V, D, R, D, D);
        gemm<0>(st, H, D, w_in + 2048, 10240, Q, D, R, D, D);
        gemm<0>(st, H, D, w_in + 3072, 10240, K, D, R, D, D);
        gemm<0>(st, H, D, w_in + 4096, 10240, RV, 2048, R, 2048, D);
        gemm<3>(st, H, D, w_in + 8192, 10240, GA, D, R, D, D);
        gemm<3>(st, H, D, w_in + 9216, 10240, GB, D, R, D, D);
        hipLaunchKernelGGL(ln_rows, dim3(R), dim3(256), 0, st, V, gm_ln_g, gm_ln_b, smp ? gv_sample : (float*)nullptr);
        hipLaunchKernelGGL(spatial_mix, dim3((unsigned)(((size_t)R * D + 255) / 256)), dim3(256), 0, st, U, V, gm_ws, gm_bs, R, lc);
        hipLaunchKernelGGL(rotary_qk, dim3((R * 512 + 255) / 256), dim3(256), 0, st, Q, K, R, L, pos0);
        hipLaunchKernelGGL(retention_rec, dim3(nseq * 8), dim3(256), 0, st, Q, K, RV, OR, smp ? state_ret : (const float*)nullptr, smp ? rs_sample : rs_prompt + (size_t)grp * 2 * 8 * 128 * 256, L);
        hipLaunchKernelGGL(head_rms, dim3((R * 8 + 3) / 4), dim3(256), 0, st, OR, R);
        gemm<5>(st, H, D, w_in + 6144, 10240, OR, 2048, R, 2048, D);
        gemm<6>(st, U, D, w_a, D, GA, D, R, D, D);
        gemm<7>(st, OR, 2048, w_b, D, GB, D, R, D, 2048, GA);
        gemm<8>(st, GB, D, w_o, D, MG, D, R, D, D, X, MOD + 5 * D, L, seq0, 1.0f);
        hipLaunchKernelGGL(norm_mod, dim3(R), dim3(256), 0, st, MG, n2_g, MOD, 6 * D, 7 * D, L, seq0, H);
        gemm<0>(st, H, D, w2_gate, DFF, G, DFF, R, DFF, D);
        gemm<4>(st, H, D, w2_up, DFF, G, DFF, R, DFF, D);
        gemm<8>(st, G, DFF, w2_down, D, X, D, R, D, DFF, MG, MOD + 8 * D, L, seq0, 0.5f);
        hipLaunchKernelGGL(norm_mod, dim3(R), dim3(256), 0, st, X, final_g, (const float*)nullptr, 0, 0, L, seq0, yout);
    }
}
}


#endif
extern "C" void kernel_launch(void* const* d_in, const int* in_sizes, int n_in, void* d_out, int out_size, void* d_ws, size_t ws_size, hipStream_t stream) {
    static int grid = 0;
    if (grid == 0) {
        if (n_in != 25 || ws_size < WS_END) { fprintf(stderr, "kernel_launch: unexpected n_in %d / ws %zu\n", n_in, ws_size); grid = -1; return; }
        int dev = 0, cus = 0, per_cu = 0;
        if (hipGetDevice(&dev) != hipSuccess || hipDeviceGetAttribute(&cus, hipDeviceAttributeMultiprocessorCount, dev) != hipSuccess) { grid = -1; return; }
        if (hipFuncSetAttribute((const void*)mega_fwd, hipFuncAttributeMaxDynamicSharedMemorySize, LDS_BYTES) != hipSuccess) { fprintf(stderr, "kernel_launch: hipFuncSetAttribute failed\n"); grid = -1; return; }
        if (hipOccupancyMaxActiveBlocksPerMultiprocessor(&per_cu, (const void*)mega_fwd, 512, LDS_BYTES) != hipSuccess || per_cu < 1) { fprintf(stderr, "kernel_launch: occupancy query says %d blocks per CU\n", per_cu); (void)hipGetLastError(); grid = -1; return; }
        grid = cus;
    }
    if (grid < 0) return;
    (void)hipMemsetAsync((char*)d_ws + WS_CTL, 0, CTL_ZERO_BYTES, stream);
    Args a; memset(&a, 0, sizeof(a));
    for (int i = 0; i < 25; ++i) a.in[i] = (const float*)d_in[i];
    a.out = (float*)d_out; a.ws = (unsigned char*)d_ws;
#ifdef DBG_PTR
    {
        const char* w0 = (const char*)d_ws; const char* w1 = w0 + ws_size; const char* o0 = (const char*)d_out; const char* o1 = o0 + (size_t)out_size * 4;
        float code = (float)((double)(ws_size >> 20) / 10000.0);
        if (o0 < w1 && w0 < o1) code += 1.0f;
        for (int i = 0; i < n_in; ++i) { const char* p0 = (const char*)d_in[i]; const char* p1 = p0 + (size_t)in_sizes[i] * 4; if (p0 < w1 && w0 < p1) code += 2.0f; if (p0 < o1 && o0 < p1) code += 4.0f; }
        nv::forward(d_in, (float*)d_out, (unsigned char*)d_ws, stream);
        hipLaunchKernelGGL(dbg_scale_imm, dim3(1024), dim3(256), 0, stream, (float*)d_out + (size_t)MP * D, (size_t)1048576, 1.0f + code);
        return; }
#endif
#ifdef DBG_SUB
    {
        float* o = (float*)d_out; unsigned char* w = (unsigned char*)d_ws; float* save = (float*)((char*)d_ws + 508 * MiB);
#if defined(DBG_DIFF) && DBG_DIFF >= 6
        (void)hipMemsetAsync((char*)d_ws + 600 * MiB, 0, 256, stream);
#endif
        for (int p = 0; p <= 5; ++p) { a.ph_lo = p; a.ph_hi = p + 1; hipLaunchKernelGGL(mega_fwd, dim3(grid), dim3(512), LDS_BYTES, stream, a); }
#if defined(DBG_DIFF) && DBG_DIFF >= 6
        {   const bf16_t* base = (const bf16_t*)(w + (DBG_DIFF == 6 ? WS_SGA : DBG_DIFF == 7 ? WS_SGB : DBG_DIFF == 8 ? WS_SGA : WS_RV)); const size_t o2 = DBG_DIFF == 8 ? 0 : (DBG_DIFF == 9 ? 0 : (size_t)MP * D); const size_t nn = DBG_DIFF == 8 ? (size_t)MP * D : (DBG_DIFF == 9 ? (size_t)MT * 2048 : (size_t)MS * D);
            hipLaunchKernelGGL(dbg_fracbad, dim3(1024), dim3(256), 0, stream, base + o2, nn, (unsigned*)((char*)d_ws + 600 * MiB) + 1);
            hipLaunchKernelGGL(dbg_frac2code, dim3(1), dim3(1), 0, stream, (unsigned*)((char*)d_ws + 600 * MiB), nn); }
#endif
        float* sc = (float*)(w + 8 * MiB); size_t off = 0; auto carve = [&](size_t n) { float* p = sc + off; off += n; return p; };
        const int R = MS, L = 8, seq0 = 8;
        float* MODn = carve((size_t)NSEQ * NMOD); float* SC = carve((size_t)NSEQ * D); float* X = carve((size_t)R * D); float* H = carve((size_t)R * D); float* G = carve((size_t)R * DFF); float* U = carve((size_t)R * D); float* V = carve((size_t)R * D);
        float* Q = carve((size_t)R * D); float* K = carve((size_t)R * D); float* RV = carve((size_t)R * 2048); float* OR = carve((size_t)R * 2048); float* GA = carve((size_t)R * D); float* GB = carve((size_t)R * D); float* MG = carve((size_t)R * D); float* Y = carve((size_t)R * D);
        const float* x_sample = (const float*)d_in[1]; const float* state_ret = (const float*)d_in[2]; const float* c_prompt = (const float*)d_in[3]; const float* c_sample = (const float*)d_in[4]; const float* w_ada = (const float*)d_in[5]; const float* b_ada = (const float*)d_in[6];
        const float* n1_g = (const float*)d_in[7]; const float* w1_gate = (const float*)d_in[8]; const float* w1_up = (const float*)d_in[9]; const float* w1_down = (const float*)d_in[10]; const float* nm_g = (const float*)d_in[11]; const float* w_in = (const float*)d_in[12];
        const float* gm_ln_g = (const float*)d_in[13]; const float* gm_ln_b = (const float*)d_in[14]; const float* gm_ws = (const float*)d_in[15]; const float* gm_bs = (const float*)d_in[16]; const float* w_a = (const float*)d_in[17]; const float* w_b = (const float*)d_in[18]; const float* w_o = (const float*)d_in[19];
        const float* n2_g = (const float*)d_in[20]; const float* w2_gate = (const float*)d_in[21]; const float* w2_up = (const float*)d_in[22]; const float* w2_down = (const float*)d_in[23]; const float* final_g = (const float*)d_in[24];
        const bf16_t* UOs = (const bf16_t*)(w + WS_UO) + (size_t)MP * UOLD;
        hipLaunchKernelGGL(nv::silu_rows, dim3((NSEQ * D + 255) / 256), dim3(256), 0, stream, c_prompt, c_sample, SC);
        nv::gemm<1>(stream, SC, D, w_ada, NMOD, MODn, NMOD, NSEQ, NMOD, D, b_ada);
        if (DBG_SUB & 1) hipLaunchKernelGGL(dbg_copy, dim3(1024), dim3(256), 0, stream, (const float*)(w + WS_MOD), MODn, (size_t)NSEQ * NMOD);
        hipLaunchKernelGGL(nv::norm_mod, dim3(R), dim3(256), 0, stream, x_sample, n1_g, (const float*)MODn, 0 * D, 1 * D, L, seq0, H);
        nv::gemm<0>(stream, H, D, w1_gate, DFF, G, DFF, R, DFF, D);
        nv::gemm<4>(stream, H, D, w1_up, DFF, G, DFF, R, DFF, D);
        nv::gemm<8>(stream, G, DFF, w1_down, D, X, D, R, D, DFF, x_sample, MODn + 2 * D, L, seq0, 0.5f);
        if (DBG_SUB & 64) hipLaunchKernelGGL(dbg_copy, dim3(1024), dim3(256), 0, stream, (const float*)(o + (size_t)MP * D), X, (size_t)R * D);
        hipLaunchKernelGGL(nv::norm_mod, dim3(R), dim3(256), 0, stream, (const float*)X, nm_g, (const float*)MODn, 3 * D, 4 * D, L, seq0, H);
        nv::gemm<2>(stream, H, D, w_in + 0, 10240, U, D, R, D, D);
        if (DBG_SUB & 2) hipLaunchKernelGGL(dbg_cvt, dim3(1024), dim3(256), 0, stream, UOs, UOLD, 0, U, R, D);
        nv::gemm<2>(stream, H, D, w_in + 1024, 10240, V, D, R, D, D);
        nv::gemm<0>(stream, H, D, w_in + 2048, 10240, Q, D, R, D, D);
        nv::gemm<0>(stream, H, D, w_in + 3072, 10240, K, D, R, D, D);
        nv::gemm<0>(stream, H, D, w_in + 4096, 10240, RV, 2048, R, 2048, D);
        if (DBG_SUB & 8) hipLaunchKernelGGL(dbg_cvt, dim3(1024), dim3(256), 0, stream, (const bf16_t*)(w + WS_RV) + (size_t)MP * 2048, 2048, 0, RV, R, 2048);
        nv::gemm<3>(stream, H, D, w_in + 8192, 10240, GA, D, R, D, D);
        nv::gemm<3>(stream, H, D, w_in + 9216, 10240, GB, D, R, D, D);
#if defined(DBG_DIFF) && DBG_DIFF < 6
        (void)hipMemsetAsync((char*)d_ws + 600 * MiB, 0, 256, stream);
        if (DBG_DIFF <= 2) hipLaunchKernelGGL(dbg_maxdiff, dim3(1024), dim3(256), 0, stream, (const float*)(DBG_DIFF == 1 ? GA : GB), (const bf16_t*)(w + (DBG_DIFF == 1 ? WS_SGA : WS_SGB)) + (size_t)MP * D, (size_t)R * D, (unsigned*)((char*)d_ws + 600 * MiB));
        else { const size_t nn = DBG_DIFF != 4 ? (size_t)R * D : (size_t)MP * D; hipLaunchKernelGGL(dbg_fracbad, dim3(1024), dim3(256), 0, stream, (const bf16_t*)(w + WS_SGA) + (DBG_DIFF != 4 ? (size_t)MP * D : (size_t)0), nn, (unsigned*)((char*)d_ws + 600 * MiB) + 1);
            hipLaunchKernelGGL(dbg_frac2code, dim3(1), dim3(1), 0, stream, (unsigned*)((char*)d_ws + 600 * MiB), nn); }
#endif
        if (DBG_SUB & 32) { hipLaunchKernelGGL(dbg_cvt, dim3(1024), dim3(256), 0, stream, (const bf16_t*)(w + WS_SGA) + (size_t)MP * D, D, 0, GA, R, D); hipLaunchKernelGGL(dbg_cvt, dim3(1024), dim3(256), 0, stream, (const bf16_t*)(w + WS_SGB) + (size_t)MP * D, D, 0, GB, R, D); }
        hipLaunchKernelGGL(nv::ln_rows, dim3(R), dim3(256), 0, stream, V, gm_ln_g, gm_ln_b, (float*)nullptr);
        hipLaunchKernelGGL(nv::spatial_mix, dim3((unsigned)(((size_t)R * D + 255) / 256)), dim3(256), 0, stream, U, (const float*)V, gm_ws, gm_bs, R, 8);
        hipLaunchKernelGGL(nv::rotary_qk, dim3((R * 512 + 255) / 256), dim3(256), 0, stream, Q, K, R, L, 16384);
        if (DBG_SUB & 4) { hipLaunchKernelGGL(dbg_cvt_perm, dim3(1024), dim3(256), 0, stream, (const bf16_t*)(w + WS_Q) + (size_t)MP * D, Q, R); hipLaunchKernelGGL(dbg_cvt_perm, dim3(1024), dim3(256), 0, stream, (const bf16_t*)(w + WS_K) + (size_t)MP * D, K, R); }
        hipLaunchKernelGGL(nv::retention_rec, dim3(128 * 8), dim3(256), 0, stream, (const float*)Q, (const float*)K, (const float*)RV, OR, state_ret, o + (size_t)MT * D + 64 * 128 * 256, 8);
        hipLaunchKernelGGL(nv::head_rms, dim3((R * 8 + 3) / 4), dim3(256), 0, stream, OR, R);
        if (DBG_SUB & 16) hipLaunchKernelGGL(dbg_mul_cvt, dim3(1024), dim3(256), 0, stream, UOs, UOLD, 1024, OR, R, 2048);
        else nv::gemm<5>(stream, H, D, w_in + 6144, 10240, OR, 2048, R, 2048, D);
        nv::gemm<6>(stream, U, D, w_a, D, GA, D, R, D, D);
        nv::gemm<7>(stream, OR, 2048, w_b, D, GB, D, R, D, 2048, GA);
        nv::gemm<8>(stream, GB, D, w_o, D, MG, D, R, D, D, X, MODn + 5 * D, L, seq0, 1.0f);
        hipLaunchKernelGGL(nv::norm_mod, dim3(R), dim3(256), 0, stream, (const float*)MG, n2_g, (const float*)MODn, 6 * D, 7 * D, L, seq0, H);
        nv::gemm<0>(stream, H, D, w2_gate, DFF, G, DFF, R, DFF, D);
        nv::gemm<4>(stream, H, D, w2_up, DFF, G, DFF, R, DFF, D);
        nv::gemm<8>(stream, G, DFF, w2_down, D, X, D, R, D, DFF, MG, MODn + 8 * D, L, seq0, 0.5f);
        hipLaunchKernelGGL(nv::norm_mod, dim3(R), dim3(256), 0, stream, (const float*)X, final_g, (const float*)nullptr, 0, 0, L, seq0, Y);
        hipLaunchKernelGGL(dbg_copy, dim3(1024), dim3(256), 0, stream, (const float*)Y, save, (size_t)1048576);
#ifdef DBG_DIFF
        hipLaunchKernelGGL(dbg_copy, dim3(1), dim3(64), 0, stream, (const float*)((char*)d_ws + 600 * MiB), save + 1048576 - 64 + 1048576 / 1048576 * 0 + 0, (size_t)0);
        hipLaunchKernelGGL(dbg_copy, dim3(1), dim3(64), 0, stream, (const float*)((char*)d_ws + 600 * MiB), (float*)((char*)d_ws + 601 * MiB), (size_t)16);
#endif
        nv::forward(d_in, o, (unsigned char*)d_ws, stream);
        hipLaunchKernelGGL(dbg_copy, dim3(1024), dim3(256), 0, stream, (const float*)save, o + (size_t)MP * D, (size_t)1048576);
#ifdef DBG_DIFF
        hipLaunchKernelGGL(dbg_scale, dim3(1024), dim3(256), 0, stream, o + (size_t)MP * D, (size_t)1048576, (const unsigned*)((char*)d_ws + 601 * MiB));
#endif
        return; }
#endif
#ifdef DBG_HYB
    {
        float* o = (float*)d_out; unsigned char* w = (unsigned char*)d_ws; float* save = (float*)((char*)d_ws + 508 * MiB);
        const int klast = DBG_HYB == 1 ? 7 : (DBG_HYB == 2 ? 9 : 5);
        for (int p = 0; p <= klast; ++p) { a.ph_lo = p; a.ph_hi = p + 1; hipLaunchKernelGGL(mega_fwd, dim3(grid), dim3(512), LDS_BYTES, stream, a); }
        float* sc = (float*)(w + 8 * MiB);
        size_t off = 0; auto carve = [&](size_t n) { float* p = sc + off; off += n; return p; };
        const int R = MS;
        float* Xs = carve((size_t)R * D); float* Hh = carve((size_t)R * D); float* G = carve((size_t)R * DFF); float* U = carve((size_t)R * D); float* ORb = carve((size_t)R * 2048);
        float* GA = carve((size_t)R * D); float* GB = carve((size_t)R * D); float* MG = carve((size_t)R * D); float* Y = carve((size_t)R * D);
        const float* MODm = (const float*)(w + WS_MOD); const float* Xm = o + (size_t)MP * D;
        const float* w_a = (const float*)d_in[17]; const float* w_b = (const float*)d_in[18]; const float* w_o = (const float*)d_in[19]; const float* n2_g = (const float*)d_in[20];
        const float* w2_gate = (const float*)d_in[21]; const float* w2_up = (const float*)d_in[22]; const float* w2_down = (const float*)d_in[23]; const float* final_g = (const float*)d_in[24];
        const bf16_t* UOs = (const bf16_t*)(w + WS_UO) + (size_t)MP * UOLD;
        if (DBG_HYB == 1) {
            hipLaunchKernelGGL(dbg_cvt, dim3(1024), dim3(256), 0, stream, UOs, UOLD, 0, U, R, D);
            hipLaunchKernelGGL(dbg_cvt, dim3(1024), dim3(256), 0, stream, UOs, UOLD, 1024, ORb, R, 2048);
            hipLaunchKernelGGL(dbg_cvt, dim3(1024), dim3(256), 0, stream, (const bf16_t*)(w + WS_SGA) + (size_t)MP * D, D, 0, GA, R, D);
            hipLaunchKernelGGL(dbg_cvt, dim3(1024), dim3(256), 0, stream, (const bf16_t*)(w + WS_SGB) + (size_t)MP * D, D, 0, GB, R, D);
            nv::gemm<6>(stream, U, D, w_a, D, GA, D, R, D, D);
            nv::gemm<7>(stream, ORb, 2048, w_b, D, GB, D, R, D, 2048, GA);
            nv::gemm<8>(stream, GB, D, w_o, D, MG, D, R, D, D, Xm, MODm + 5 * D, 8, 8, 1.0f);
        } else if (DBG_HYB == 3) {
            float* V = carve((size_t)R * D); float* Q = carve((size_t)R * D); float* K = carve((size_t)R * D); float* RV = carve((size_t)R * 2048);
            const float* gm_ln_g = (const float*)d_in[13]; const float* gm_ln_b = (const float*)d_in[14]; const float* gm_ws = (const float*)d_in[15]; const float* gm_bs = (const float*)d_in[16]; const float* state_ret = (const float*)d_in[2];
            hipLaunchKernelGGL(dbg_cvt, dim3(1024), dim3(256), 0, stream, UOs, UOLD, 0, U, R, D);
            hipLaunchKernelGGL(dbg_cvt, dim3(1024), dim3(256), 0, stream, (const bf16_t*)(w + WS_V) + (size_t)MP * D, D, 0, V, R, D);
            hipLaunchKernelGGL(dbg_cvt_perm, dim3(1024), dim3(256), 0, stream, (const bf16_t*)(w + WS_Q) + (size_t)MP * D, Q, R);
            hipLaunchKernelGGL(dbg_cvt_perm, dim3(1024), dim3(256), 0, stream, (const bf16_t*)(w + WS_K) + (size_t)MP * D, K, R);
            hipLaunchKernelGGL(dbg_cvt, dim3(1024), dim3(256), 0, stream, (const bf16_t*)(w + WS_RV) + (size_t)MP * 2048, 2048, 0, RV, R, 2048);
            hipLaunchKernelGGL(dbg_cvt, dim3(1024), dim3(256), 0, stream, (const bf16_t*)(w + WS_SGA) + (size_t)MP * D, D, 0, GA, R, D);
            hipLaunchKernelGGL(dbg_cvt, dim3(1024), dim3(256), 0, stream, (const bf16_t*)(w + WS_SGB) + (size_t)MP * D, D, 0, GB, R, D);
            hipLaunchKernelGGL(nv::ln_rows, dim3(R), dim3(256), 0, stream, V, gm_ln_g, gm_ln_b, (float*)nullptr);
            hipLaunchKernelGGL(nv::spatial_mix, dim3((unsigned)(((size_t)R * D + 255) / 256)), dim3(256), 0, stream, U, (const float*)V, gm_ws, gm_bs, R, 8);
            hipLaunchKernelGGL(nv::retention_rec, dim3(128 * 8), dim3(256), 0, stream, (const float*)Q, (const float*)K, (const float*)RV, ORb, state_ret, o + (size_t)MT * D + 64 * 128 * 256, 8);
            hipLaunchKernelGGL(nv::head_rms, dim3((R * 8 + 3) / 4), dim3(256), 0, stream, ORb, R);
            hipLaunchKernelGGL(dbg_mul_cvt, dim3(1024), dim3(256), 0, stream, UOs, UOLD, 1024, ORb, R, 2048);
            nv::gemm<6>(stream, U, D, w_a, D, GA, D, R, D, D);
            nv::gemm<7>(stream, ORb, 2048, w_b, D, GB, D, R, D, 2048, GA);
            nv::gemm<8>(stream, GB, D, w_o, D, MG, D, R, D, D, Xm, MODm + 5 * D, 8, 8, 1.0f);
        } else {
            hipLaunchKernelGGL(dbg_copy, dim3(1024), dim3(256), 0, stream, Xm, MG, (size_t)R * D);
        }
        hipLaunchKernelGGL(nv::norm_mod, dim3(R), dim3(256), 0, stream, (const float*)MG, n2_g, MODm, 6 * D, 7 * D, 8, 8, Hh);
        nv::gemm<0>(stream, Hh, D, w2_gate, DFF, G, DFF, R, DFF, D);
        nv::gemm<4>(stream, Hh, D, w2_up, DFF, G, DFF, R, DFF, D);
        nv::gemm<8>(stream, G, DFF, w2_down, D, Xs, D, R, D, DFF, MG, MODm + 8 * D, 8, 8, 0.5f);
        hipLaunchKernelGGL(nv::norm_mod, dim3(R), dim3(256), 0, stream, (const float*)Xs, final_g, (const float*)nullptr, 0, 0, 8, 8, Y);
        hipLaunchKernelGGL(dbg_copy, dim3(1024), dim3(256), 0, stream, (const float*)Y, save, (size_t)1048576);
        nv::forward(d_in, o, (unsigned char*)d_ws, stream);
        hipLaunchKernelGGL(dbg_copy, dim3(1024), dim3(256), 0, stream, (const float*)save, o + (size_t)MP * D, (size_t)1048576);
        return; }
#endif
#ifdef DBG_MIX
    {   float* o = (float*)d_out; float* save = (float*)((char*)d_ws + 508 * MiB);
        const size_t off = DBG_MIX == 1 ? (size_t)54525952 - 1048576 : (size_t)MP * D;
        for (int p = 0; p < NPHASE; ++p) { a.ph_lo = p; a.ph_hi = p + 1; hipLaunchKernelGGL(mega_fwd, dim3(grid), dim3(512), LDS_BYTES, stream, a); }
        hipLaunchKernelGGL(dbg_copy, dim3(1024), dim3(256), 0, stream, (const float*)(o + off), save, (size_t)1048576);
        nv::forward(d_in, o, (unsigned char*)d_ws, stream);
        hipLaunchKernelGGL(dbg_copy, dim3(1024), dim3(256), 0, stream, (const float*)save, o + off, (size_t)1048576);
        return; }
#endif
#ifdef DBG_CK
    {   unsigned long long* ck = (unsigned long long*)((char*)d_ws + 508 * MiB);
        (void)hipMemsetAsync(ck, 0, 4096, stream);
        for (int run = 0; run < DBG_CK; ++run) {
            (void)hipMemsetAsync((char*)d_ws + WS_CTL, 0, CTL_ZERO_BYTES, stream);
            for (int p = 0; p < NPHASE; ++p) { a.ph_lo = p; a.ph_hi = p + 1; hipLaunchKernelGGL(mega_fwd, dim3(grid), dim3(512), LDS_BYTES, stream, a);
                hipLaunchKernelGGL(dbg_cksum, dim3(2048), dim3(256), 0, stream, (const unsigned*)d_ws, (size_t)(508 * MiB / 4), ck + 16 * run + p);
                hipLaunchKernelGGL(dbg_cksum, dim3(2048), dim3(256), 0, stream, (const unsigned*)d_out, (size_t)out_size, ck + 16 * run + p); }
        }
        hipLaunchKernelGGL(dbg_encode, dim3(1024), dim3(256), 0, stream, ck, (float*)d_out + (size_t)MP * D, (size_t)MS * D, NPHASE);
        return; }
#endif
#ifdef DBG_LAST
    {   float* o = (float*)d_out; unsigned char* w = (unsigned char*)d_ws; const size_t NT = (size_t)MT * D;
        for (int p = 0; p <= DBG_LAST; ++p) { a.ph_lo = p; a.ph_hi = p + 1; hipLaunchKernelGGL(mega_fwd, dim3(grid), dim3(512), LDS_BYTES, stream, a); }
#if DBG_LAST == 5
        hipLaunchKernelGGL(dbg_dump_bf16, dim3(2048), dim3(256), 0, stream, (const bf16_t*)(w + WS_Q), o, NT);
        hipLaunchKernelGGL(dbg_dump_bf16, dim3(2048), dim3(256), 0, stream, (const bf16_t*)(w + WS_K), o + NT, NT);
        hipLaunchKernelGGL(dbg_dump_bf16, dim3(2048), dim3(256), 0, stream, (const bf16_t*)(w + WS_V), o + 2 * NT, NT);
        hipLaunchKernelGGL(dbg_fill, dim3(2048), dim3(256), 0, stream, o + 3 * NT, (size_t)out_size - 3 * NT);
#endif
        return; }
#endif
#if MK_PER_PHASE
    for (int p = 0; p < NPHASE; ++p) { a.ph_lo = p; a.ph_hi = p + 1; hipLaunchKernelGGL(mega_fwd, dim3(grid), dim3(512), LDS_BYTES, stream, a); }
#else
    a.ph_lo = 0; a.ph_hi = NPHASE; hipLaunchKernelGGL(mega_fwd, dim3(grid), dim3(512), LDS_BYTES, stream, a);
#endif
}
```
